# Optimizing an MI355X kernel written in HIP

```python
import jax, jax.numpy as jnp
from jax import lax
import numpy as np


D_MODEL = 1024
BATCH = 2
SEQ = 8192
DEPTH = 4
DEC_BATCH = 8
DEC_SEQ = 32
PAST_LEN = 4096

CHUNK = 64
WINDOW = 128
N_HEADS = 8
N_KV_HEADS = 2
HEAD_DIM = 64
ATT_W = N_HEADS * HEAD_DIM
KV_W = N_KV_HEADS * HEAD_DIM
CONV_W = 512
CONV_K = 3
X_HEADS = 4
X_HEAD_DIM = 128
X_W = X_HEADS * X_HEAD_DIM
N_MEM = 256
N_BRANCH = 3
EPS = 1e-6
SPLIT_SIZES = (ATT_W, KV_W, KV_W, ATT_W, CONV_W, CONV_W, CONV_W, CONV_W, X_W, X_W, N_BRANCH * D_MODEL)
IN_W = sum(SPLIT_SIZES)
SPLIT_POINTS = tuple(int(p) for p in np.cumsum(SPLIT_SIZES)[:-1])

kernel_name = 'hybrid_swa_sink_shortconv_memxattn_stream_step'


def rmsnorm(x, g):
    x32 = x.astype(jnp.float32)
    y = x32 * lax.rsqrt(jnp.mean(x32 * x32, axis=-1, keepdims=True) + EPS)
    return (y * g.astype(jnp.float32)).astype(x.dtype)


def alibi_slopes(n):
    return jnp.power(2.0, -8.0 * jnp.arange(1, n + 1, dtype=jnp.float32) / n)


def band_attention(q, kb, vb, qpos, kpos, valid, sink):
    B, N, Q, H, D = q.shape
    G = H // N_KV_HEADS
    qg = q.reshape(B, N, Q, N_KV_HEADS, G, D)
    s = jnp.einsum('bnqkgd,bnskd->bnkgqs', qg, kb).astype(jnp.float32) * (D ** -0.5)
    dist = jnp.abs(qpos[:, :, None] - kpos[:, None, :]).astype(jnp.float32)
    slope = alibi_slopes(H).reshape(N_KV_HEADS, G)[None, None, :, :, None, None]
    s = s - slope * dist[None, :, None, None, :, :]
    s = jnp.where(valid[None, :, None, None, None, :], s, -jnp.inf)
    sink_b = sink.astype(jnp.float32).reshape(N_KV_HEADS, G)[None, None, :, :, None, None]
    m = jnp.maximum(jnp.max(s, axis=-1, keepdims=True), sink_b)
    p = jnp.exp(s - m)
    p = p / (jnp.sum(p, axis=-1, keepdims=True) + jnp.exp(sink_b - m))
    o = jnp.einsum('bnkgqs,bnskd->bnqkgd', p.astype(vb.dtype), vb)
    return o.reshape(B, N, Q, H * D)


def prompt_window_attention(q, k, v, sink):
    B, S = q.shape[:2]
    nc = S // CHUNK
    lb = WINDOW // CHUNK
    pad = ((0, 0), (WINDOW, 0), (0, 0), (0, 0))
    kp = jnp.pad(k, pad).reshape(B, nc + lb, CHUNK, N_KV_HEADS, HEAD_DIM)
    vp = jnp.pad(v, pad).reshape(B, nc + lb, CHUNK, N_KV_HEADS, HEAD_DIM)
    kb = jnp.concatenate([kp[:, j:j + nc] for j in range(lb + 1)], axis=2)
    vb = jnp.concatenate([vp[:, j:j + nc] for j in range(lb + 1)], axis=2)
    qb = q.reshape(B, nc, CHUNK, N_HEADS, HEAD_DIM)
    c0 = jnp.arange(nc)[:, None] * CHUNK
    qpos = c0 + jnp.arange(CHUNK)[None, :]
    kpos = c0 - WINDOW + jnp.arange((lb + 1) * CHUNK)[None, :]
    o = band_attention(qb, kb, vb, qpos, kpos, kpos >= 0, sink)
    return o.reshape(B, S, ATT_W)


def sample_window_attention(q, k, v, ck, cv, sink):
    B, T = q.shape[:2]
    W = ck.shape[1]
    kb = jnp.concatenate([ck, k], axis=1)[:, None]
    vb = jnp.concatenate([cv, v], axis=1)[:, None]
    qpos = (PAST_LEN + jnp.arange(T))[None, :]
    kpos = (PAST_LEN - W + jnp.arange(W + T))[None, :]
    valid = jnp.ones((1, W + T), dtype=bool)
    o = band_attention(q[:, None], kb, vb, qpos, kpos, valid, sink)
    return o.reshape(B, T, ATT_W)


def conv3(up, w, b):
    T = up.shape[1] - (CONV_K - 1)
    return sum(up[:, j:j + T] * w[j] for j in range(CONV_K)) + b


def memory_kv(mem, g, wk, wv):
    B, M = mem.shape[:2]
    mn = rmsnorm(mem, g)
    mk = (mn @ wk).reshape(B, M, X_HEADS, X_HEAD_DIM)
    mv = (mn @ wv).reshape(B, M, X_HEADS, X_HEAD_DIM)
    return mk, mv


def cross_attention(q, mk, mv):
    B, T = q.shape[:2]
    s = jnp.einsum('bthd,bmhd->bhtm', q, mk).astype(jnp.float32) * (X_HEAD_DIM ** -0.5)
    p = jax.nn.softmax(s, axis=-1).astype(mv.dtype)
    return jnp.einsum('bhtm,bmhd->bthd', p, mv).reshape(B, T, X_W)


def split_inputs(x, g, w):
    return jnp.split(rmsnorm(x, g) @ w, SPLIT_POINTS, axis=-1)


def merge_branches(attn, ga, conv, bb, gb, xattn, gx, mg, w_pa, w_pb, w_px, w_out):
    ya = (attn * jax.nn.silu(ga)) @ w_pa
    yb = (bb * conv * jax.nn.silu(gb)) @ w_pb
    yx = (xattn * jax.nn.silu(gx)) @ w_px
    sa, sb, sx = jnp.split(jax.nn.sigmoid(mg), N_BRANCH, axis=-1)
    return (sa * ya + sb * yb + sx * yx) @ w_out


def setup_inputs(seed: int = 0) -> dict:
    key = jax.random.key(seed)
    ks = jax.random.split(key, 24)
    f32 = jnp.float32
    win = min(WINDOW, PAST_LEN)
    nrm = lambda k, shape, s: (jax.random.normal(k, shape, f32) * s).astype(f32)
    return {
        'x_prompt': nrm(ks[0], (BATCH, SEQ, D_MODEL), 1.0),
        'x_sample': nrm(ks[1], (DEC_BATCH, DEC_SEQ, D_MODEL), 1.0),
        'cache_attn_k': nrm(ks[2], (DEPTH, DEC_BATCH, win, N_KV_HEADS, HEAD_DIM), 1.0),
        'cache_attn_v': nrm(ks[3], (DEPTH, DEC_BATCH, win, N_KV_HEADS, HEAD_DIM), 1.0),
        'cache_conv': nrm(ks[4], (DEPTH, DEC_BATCH, CONV_K - 1, CONV_W), 1.0),
        'cache_mem_k': nrm(ks[5], (DEPTH, DEC_BATCH, N_MEM, X_HEADS, X_HEAD_DIM), 1.0),
        'cache_mem_v': nrm(ks[6], (DEPTH, DEC_BATCH, N_MEM, X_HEADS, X_HEAD_DIM), 1.0),
        'mem_prompt': nrm(ks[7], (BATCH, N_MEM, D_MODEL), 1.0),
        'norm_g': 1.0 + nrm(ks[8], (DEPTH, D_MODEL), 0.02),
        'w_in': nrm(ks[9], (DEPTH, D_MODEL, IN_W), D_MODEL ** -0.5),
        'attn_sink': nrm(ks[10], (DEPTH, N_HEADS), 0.5),
        'w_pa': nrm(ks[11], (DEPTH, ATT_W, D_MODEL), ATT_W ** -0.5),
        'conv_w': nrm(ks[12], (DEPTH, CONV_K, CONV_W), CONV_K ** -0.5),
        'conv_b': nrm(ks[13], (DEPTH, CONV_W), 0.01),
        'w_pb': nrm(ks[14], (DEPTH, CONV_W, D_MODEL), CONV_W ** -0.5),
        'mem_norm_g': 1.0 + nrm(ks[15], (DEPTH, D_MODEL), 0.02),
        'w_mk': nrm(ks[16], (DEPTH, D_MODEL, X_W), D_MODEL ** -0.5),
        'w_mv': nrm(ks[17], (DEPTH, D_MODEL, X_W), D_MODEL ** -0.5),
        'w_px': nrm(ks[18], (DEPTH, X_W, D_MODEL), X_W ** -0.5),
        'w_out': nrm(ks[19], (DEPTH, D_MODEL, D_MODEL), D_MODEL ** -0.5),
        'final_g': 1.0 + nrm(ks[20], (D_MODEL,), 0.02),
    }


def reference(x_prompt, x_sample, cache_attn_k, cache_attn_v, cache_conv, cache_mem_k, cache_mem_v,
              mem_prompt, norm_g, w_in, attn_sink, w_pa, conv_w, conv_b, w_pb, mem_norm_g,
              w_mk, w_mv, w_px, w_out, final_g):
    xp = x_prompt
    xs = x_sample
    Bp, S = xp.shape[:2]
    Bs, T = xs.shape[:2]
    win_p = min(WINDOW, S)
    pk, pv, pc, pmk, pmv = [], [], [], [], []
    sk, sv, sc = [], [], []
    for l in range(DEPTH):
        q, k, v, ga, bb, cc, hh, gb, xq, gx, mg = split_inputs(xp, norm_g[l], w_in[l])
        q = q.reshape(Bp, S, N_HEADS, HEAD_DIM)
        k = k.reshape(Bp, S, N_KV_HEADS, HEAD_DIM)
        v = v.reshape(Bp, S, N_KV_HEADS, HEAD_DIM)
        attn = prompt_window_attention(q, k, v, attn_sink[l])
        up = jnp.pad(cc * hh, ((0, 0), (CONV_K - 1, 0), (0, 0)))
        conv = conv3(up, conv_w[l], conv_b[l])
        mk, mv = memory_kv(mem_prompt, mem_norm_g[l], w_mk[l], w_mv[l])
        xattn = cross_attention(xq.reshape(Bp, S, X_HEADS, X_HEAD_DIM), mk, mv)
        xp = xp + merge_branches(attn, ga, conv, bb, gb, xattn, gx, mg, w_pa[l], w_pb[l], w_px[l], w_out[l])
        pk.append(k[:, S - win_p:])
        pv.append(v[:, S - win_p:])
        pc.append(up[:, up.shape[1] - (CONV_K - 1):])
        pmk.append(mk)
        pmv.append(mv)
        q, k, v, ga, bb, cc, hh, gb, xq, gx, mg = split_inputs(xs, norm_g[l], w_in[l])
        q = q.reshape(Bs, T, N_HEADS, HEAD_DIM)
        k = k.reshape(Bs, T, N_KV_HEADS, HEAD_DIM)
        v = v.reshape(Bs, T, N_KV_HEADS, HEAD_DIM)
        attn = sample_window_attention(q, k, v, cache_attn_k[l], cache_attn_v[l], attn_sink[l])
        up = jnp.concatenate([cache_conv[l].astype(cc.dtype), cc * hh], axis=1)
        conv = conv3(up, conv_w[l], conv_b[l])
        xattn = cross_attention(xq.reshape(Bs, T, X_HEADS, X_HEAD_DIM), cache_mem_k[l], cache_mem_v[l])
        xs = xs + merge_branches(attn, ga, conv, bb, gb, xattn, gx, mg, w_pa[l], w_pb[l], w_px[l], w_out[l])
        sk.append(k)
        sv.append(v)
        sc.append(up[:, up.shape[1] - (CONV_K - 1):])
    y_prompt = rmsnorm(xp, final_g)
    y_sample = rmsnorm(xs, final_g)
    return (y_prompt, y_sample,
            jnp.stack(pk), jnp.stack(pv), jnp.stack(pc), jnp.stack(pmk), jnp.stack(pmv),
            jnp.stack(sk), jnp.stack(sv), jnp.stack(sc))
```

```cpp
#include <hip/hip_runtime.h>
#include <hip/hip_bf16.h>
#include <cstdio>
#include <cstdint>

#ifndef MK_N_LAUNCHES
#define MK_N_LAUNCHES 1
#endif
#ifndef PROBE_DUP
#define PROBE_DUP 0
#endif

constexpr int DM = 1024, NBATCH = 2, SEQ = 8192, DEPTH = 4, DECB = 8, DECS = 32;
constexpr int MP = NBATCH * SEQ, MS = DECB * DECS, MT = MP + MS;
constexpr int NIN = 7424;
constexpr int NMEM = 256, MEMROWS = NBATCH * NMEM;
constexpr float EPS = 1e-6f;
constexpr float LOG2E = 1.4426950408889634f;
constexpr float QSCALE = 0.125f * LOG2E;

constexpr size_t O_YP = 0, O_YS = 16777216, O_KP = 17039360, O_VP = 17170432, O_CP = 17301504, O_MKP = 17309696, O_MVP = 18358272,
                 O_KS = 19406848, O_VS = 19537920, O_CS = 19668992, O_TOTAL = 19701760;

constexpr size_t MiB = 1u << 20;
constexpr size_t WS_CTL = 0, CTL_ZERO_BYTES = 1 * MiB;
constexpr size_t WS_SS = 256 * 1024;
constexpr size_t WS_WIN = 2 * MiB;
constexpr size_t WS_WP = 60 * MiB;
constexpr size_t WS_WO = 72 * MiB;
constexpr size_t WS_WM = 80 * MiB;
constexpr size_t WS_XB = 88 * MiB;
constexpr size_t WS_MEMB = 121 * MiB;
constexpr size_t WS_RMEM = 122 * MiB;
constexpr size_t WS_CKB = 123 * MiB, WS_CVB = 124 * MiB;
constexpr size_t WS_CMK = 125 * MiB, WS_CMV = 133 * MiB;
constexpr size_t WS_MK = 141 * MiB, WS_MV = 143 * MiB;
constexpr size_t WS_MG = 145 * MiB;
constexpr size_t WS_ABX = 243 * MiB;
constexpr size_t WS_Q = 292 * MiB, WS_GA = 309 * MiB, WS_U = 326 * MiB, WS_WB = 343 * MiB, WS_XQ = 360 * MiB, WS_GX = 377 * MiB;
constexpr size_t WS_K = 394 * MiB, WS_V = 399 * MiB;
constexpr size_t WS_ZF = 292 * MiB;
constexpr size_t WS_ZB = 404 * MiB;
constexpr size_t WS_END = 437 * MiB;
static_assert(WS_SS + 5 * (size_t)MT * 4 <= CTL_ZERO_BYTES, "SS inside memset region");
static_assert(WS_WIN + (size_t)4 * NIN * 1024 * 2 <= WS_WP && WS_XB + (size_t)MT * 1024 * 2 <= WS_MEMB && WS_MG + (size_t)MT * 3072 * 2 <= WS_ABX &&
              WS_ABX + (size_t)MT * 1536 * 2 <= WS_Q && WS_Q + (size_t)MT * 512 * 2 <= WS_GA && WS_K + (size_t)MT * 128 * 2 <= WS_V && WS_V + (size_t)MT * 128 * 2 <= WS_END &&
              WS_ZF + (size_t)MT * 1024 * 4 <= WS_K && WS_ZB + (size_t)MT * 1024 * 2 <= WS_END, "ws map");

typedef unsigned short bf16_t;
typedef short bf16x8 __attribute__((ext_vector_type(8)));
typedef short s16x4 __attribute__((ext_vector_type(4)));
typedef float f32x4 __attribute__((ext_vector_type(4)));
typedef float f32x16 __attribute__((ext_vector_type(16)));
typedef unsigned u32x4 __attribute__((ext_vector_type(4)));
typedef unsigned u32x2 __attribute__((ext_vector_type(2)));
#define LAS __attribute__((address_space(3)))
#define GAS __attribute__((address_space(1)))

__device__ __forceinline__ unsigned cvt_pk_bf16(float lo, float hi) { unsigned r; asm volatile("v_cvt_pk_bf16_f32 %0, %1, %2" : "=v"(r) : "v"(lo), "v"(hi)); return r; }
__device__ __forceinline__ float bf_lo(unsigned w) { return __uint_as_float(w << 16); }
__device__ __forceinline__ float bf_hi(unsigned w) { return __uint_as_float(w & 0xffff0000u); }
__device__ __forceinline__ float sigmoidf_(float x) { return __builtin_amdgcn_rcpf(1.f + __builtin_amdgcn_exp2f(-x * LOG2E)); }
__device__ __forceinline__ float siluf_(float x) { return x * sigmoidf_(x); }
__device__ __forceinline__ void st8(bf16_t* p, f32x4 v0, f32x4 v1) { u32x4 w; w.x = cvt_pk_bf16(v0[0], v0[1]); w.y = cvt_pk_bf16(v0[2], v0[3]); w.z = cvt_pk_bf16(v1[0], v1[1]); w.w = cvt_pk_bf16(v1[2], v1[3]); *(u32x4*)p = w; }

__device__ __forceinline__ void st8_wt(bf16_t* p, f32x4 v0, f32x4 v1) { u32x4 w; w.x = cvt_pk_bf16(v0[0], v0[1]); w.y = cvt_pk_bf16(v0[2], v0[3]); w.z = cvt_pk_bf16(v1[0], v1[1]); w.w = cvt_pk_bf16(v1[2], v1[3]);
    asm volatile("global_store_dwordx4 %0, %1, off sc1\n\ts_nop 1" :: "v"(p), "v"(w) : "memory"); }

namespace pg8 {
constexpr int BM = 256, BK = 64, HALF = 128, HTB = HALF * BK * 2, STAGE_BYTES = 8 * HTB, NXCD = 8, WGM = 8;
__host__ __device__ __forceinline__ int lds_byte(int r, int c) { const int st = (r >> 4) * 2 + (c >> 5), rr = r & 15, cc = c & 31, ob = rr * 64 + cc * 2; return st * 1024 + (ob ^ (((ob >> 9) & 1) << 5)); }
__host__ __device__ __forceinline__ void stage_rc(int b, int& R, int& C) { const int st = b / 1024, sb = b % 1024, swz = sb ^ (((sb >> 9) & 1) << 5); R = (st >> 1) * 16 + swz / 64; C = (st & 1) * 32 + (swz % 64) / 2; }
__host__ __device__ __forceinline__ int perm32(int rho) { const int n = rho >> 4, i = rho & 15; return 8 * (i >> 2) + 4 * n + (i & 3); }

struct Unit { int pm, pn, z; };
struct Gemm { const char* A; const char* B; int lda, ldb, K; long azstep, bzstep; };

struct Sched {
    int nM, nN, nwg, G, c, nz, nextra;
    __device__ void init(int M, int N, int G_, int c_, int nz_, int nextra_) { nM = M / BM; nN = N / BM; nwg = nM * nN; G = G_; c = c_; nz = nz_; nextra = nextra_; }
    __device__ bool next(int i, Unit& u) const {
        const int round = i / nz; u.z = i - round * nz;
        const long L = (long)round * G + c; if (L >= nwg + nextra) return false;
        if (L >= nwg) { const int j = (int)(L - nwg); u.pm = j & 1; u.pn = j >> 1; u.z = 1; return true; }
        int wgid = (int)L; { const int q = nwg / NXCD, r = nwg % NXCD, xcd = wgid % NXCD, off = wgid / NXCD; wgid = (xcd < r ? xcd * (q + 1) : r * (q + 1) + (xcd - r) * q) + off; }
        const int nig = WGM * nN, gid = wgid / nig, fm = gid * WGM, gsz = (nM - fm) < WGM ? (nM - fm) : WGM;
        u.pm = fm + ((wgid % nig) % gsz); u.pn = (wgid % nig) / gsz; return true;
    }
};

struct SchedS {
    int pm, pn0, pnstep, npn, nz;
    __device__ bool next(int i, Unit& u) const { const int round = i / nz; const int pn = pn0 + round * pnstep; if (pn >= npn) return false; u.pm = pm; u.pn = pn; u.z = i - round * nz; return true; }
};

template <class Epi, class SchedT, bool ALIGN_EPI, bool SP2>
__device__ __forceinline__ void gemm_phase(LAS unsigned char* lds, const Gemm g, const SchedT& S, const Epi& E) {
    int tid = threadIdx.x; asm volatile("" : "+v"(tid));
    const int wid = __builtin_amdgcn_readfirstlane(tid >> 6), lane = tid & 63, wr = wid >> 2, wc = wid & 3, fr = lane & 15, fq = lane >> 4;
    const int nt = g.K / BK;
    unsigned voffA[2], voffB[2];
#pragma unroll
    for (int i = 0; i < 2; ++i) { int R, C; stage_rc(tid * 16 + i * 8192, R, C); const int Rb = Epi::PERM ? ((R & ~31) + perm32(R & 31)) : R;
        voffA[i] = (unsigned)(R * g.lda + C) * 2u; voffB[i] = (unsigned)(Rb * g.ldb + C) * 2u; }
    const size_t kstep = (size_t)(BK * 2);
    const size_t hstepA = (size_t)HALF * g.lda * 2, hstepB = (size_t)HALF * g.ldb * 2;
    const size_t tstepA = 2 * hstepA, tstepB = 2 * hstepB;
    const unsigned ldsw = (unsigned)wid * 1024u;
    const int aoff = lds_byte(wr * 64 + fr, fq * 8), boff = lds_byte(wc * 32 + fr, fq * 8);
#define PG8_SA(b, h) (((b) * 2 + (h)) * HTB)
#define PG8_SB(b, h) ((4 + (b) * 2 + (h)) * HTB)
#define PG8_STAGE(bufoff, gbase, voff) do { _Pragma("unroll") for (int _i = 0; _i < 2; ++_i) \
        __builtin_amdgcn_global_load_lds((const unsigned*)((const char*)(gbase) + (voff)[_i]), (LAS unsigned*)(lds + (bufoff) + ldsw + _i * 8192), 16, 0, 0); } while (0)
#define PG8_LDA(dst, b, h) do { _Pragma("unroll") for (int m = 0; m < 4; ++m) _Pragma("unroll") for (int k = 0; k < 2; ++k) dst[m][k] = *(const LAS bf16x8*)(lds + PG8_SA(b, h) + aoff + m * 2048 + k * 1024); } while (0)
#define PG8_LDB(dst, b, h) do { _Pragma("unroll") for (int n = 0; n < 2; ++n) _Pragma("unroll") for (int k = 0; k < 2; ++k) dst[n][k] = *(const LAS bf16x8*)(lds + PG8_SB(b, h) + boff + n * 2048 + k * 1024); } while (0)
#define PG8_MMA(ai, bj, At, Bt) do { __builtin_amdgcn_s_setprio(1); _Pragma("unroll") for (int m = 0; m < 4; ++m) _Pragma("unroll") for (int n = 0; n < 2; ++n) _Pragma("unroll") for (int k = 0; k < 2; ++k) \
        acc[ai][bj][m][n] = __builtin_amdgcn_mfma_f32_16x16x32_bf16(Bt[n][k], At[m][k], acc[ai][bj][m][n], 0, 0, 0); __builtin_amdgcn_s_setprio(0); } while (0)
#define PG8_WAIT_V(n) asm volatile("s_waitcnt vmcnt(" #n ")" ::: "memory")
#define PG8_WAIT_L(n) asm volatile("s_waitcnt lgkmcnt(" #n ")" ::: "memory")
#define PG8_BAR __builtin_amdgcn_s_barrier()
#define PG8_SCHED __builtin_amdgcn_sched_barrier(0)
    Unit cur, nxt; int ui = 0;
    if (!S.next(0, cur)) return;
    f32x4 acc[2][2][4][2];
#pragma unroll
    for (int a = 0; a < 2; ++a)
#pragma unroll
        for (int b = 0; b < 2; ++b)
#pragma unroll
            for (int m = 0; m < 4; ++m)
#pragma unroll
                for (int n = 0; n < 2; ++n) acc[a][b][m][n] = (f32x4){0.f, 0.f, 0.f, 0.f};
    bf16x8 At[4][2], B0[2][2], B1[2][2];
    const char* cA = g.A + (size_t)cur.pm * tstepA + (long)cur.z * g.azstep; const char* cB = g.B + (size_t)cur.pn * tstepB + (long)cur.z * g.bzstep;
    if constexpr (SP2) {
        PG8_STAGE(PG8_SB(0, 0), cB, voffB); PG8_STAGE(PG8_SB(0, 1), cB + hstepB, voffB); PG8_STAGE(PG8_SA(0, 0), cA, voffA); PG8_STAGE(PG8_SA(0, 1), cA + hstepA, voffA);
        if (wr == 1) PG8_BAR;
        PG8_WAIT_V(2); PG8_BAR;
        PG8_STAGE(PG8_SB(1, 0), cB + kstep, voffB); PG8_STAGE(PG8_SA(1, 0), cA + kstep, voffA); PG8_STAGE(PG8_SB(1, 1), cB + hstepB + kstep, voffB);
        PG8_WAIT_V(6); PG8_BAR;
    } else {
        PG8_STAGE(PG8_SB(0, 0), cB, voffB); PG8_STAGE(PG8_SA(0, 0), cA, voffA); PG8_STAGE(PG8_SB(0, 1), cB + hstepB, voffB); PG8_STAGE(PG8_SA(0, 1), cA + hstepA, voffA);
        if (wr == 1) PG8_BAR;
        PG8_WAIT_V(4); PG8_BAR;
        PG8_STAGE(PG8_SB(1, 0), cB + kstep, voffB); PG8_STAGE(PG8_SA(1, 0), cA + kstep, voffA); PG8_STAGE(PG8_SB(1, 1), cB + hstepB + kstep, voffB);
        PG8_WAIT_V(6); PG8_BAR;
    }
    for (;;) {
        const bool has_next = S.next(ui + 1, nxt);
        const char* nA = has_next ? g.A + (size_t)nxt.pm * tstepA + (long)nxt.z * g.azstep : cA; const char* nB = has_next ? g.B + (size_t)nxt.pn * tstepB + (long)nxt.z * g.bzstep : cB;
        for (int t = 0; t < nt; t += 2) {
            const bool last = (t == nt - 2);
            const char* a1 = cA + (size_t)(t + 1) * kstep;
            const char* a2 = last ? nA : cA + (size_t)(t + 2) * kstep; const char* b2 = last ? nB : cB + (size_t)(t + 2) * kstep;
            const char* a3 = a2 + kstep; const char* b3 = b2 + kstep;
            if constexpr (SP2) {
            PG8_LDB(B0, 0, 0); PG8_LDB(B1, 0, 1); PG8_SCHED; PG8_LDA(At, 0, 0); PG8_STAGE(PG8_SA(1, 1), a1 + hstepA, voffA);
            PG8_WAIT_V(8); PG8_WAIT_L(0); PG8_BAR; PG8_MMA(0, 0, At, B0); PG8_MMA(0, 1, At, B1); PG8_BAR; PG8_SCHED;
            PG8_LDA(At, 0, 1); PG8_STAGE(PG8_SB(0, 0), b2, voffB); PG8_STAGE(PG8_SB(0, 1), b2 + hstepB, voffB); PG8_STAGE(PG8_SA(0, 0), a2, voffA);
            PG8_WAIT_V(8); PG8_WAIT_L(0); PG8_BAR; PG8_MMA(1, 0, At, B0); PG8_MMA(1, 1, At, B1); PG8_BAR; PG8_SCHED;
            PG8_LDB(B0, 1, 0); PG8_LDB(B1, 1, 1); PG8_SCHED; PG8_LDA(At, 1, 0); PG8_STAGE(PG8_SA(0, 1), a2 + hstepA, voffA);
            PG8_WAIT_V(8); PG8_WAIT_L(0); PG8_BAR; PG8_MMA(0, 0, At, B0); PG8_MMA(0, 1, At, B1); PG8_BAR; PG8_SCHED;
            PG8_LDA(At, 1, 1); PG8_STAGE(PG8_SB(1, 0), b3, voffB); PG8_STAGE(PG8_SB(1, 1), b3 + hstepB, voffB); PG8_STAGE(PG8_SA(1, 0), a3, voffA);
            PG8_WAIT_V(8); PG8_WAIT_L(0); PG8_BAR; PG8_MMA(1, 0, At, B0); PG8_MMA(1, 1, At, B1); PG8_BAR; PG8_SCHED;
            } else {
            PG8_LDB(B0, 0, 0); PG8_SCHED; PG8_LDA(At, 0, 0); PG8_STAGE(PG8_SA(1, 1), a1 + hstepA, voffA);
            PG8_WAIT_L(8); PG8_BAR; PG8_WAIT_L(0); PG8_MMA(0, 0, At, B0); PG8_BAR; PG8_SCHED;
            PG8_LDB(B1, 0, 1); PG8_STAGE(PG8_SB(0, 0), b2, voffB);
            PG8_BAR; PG8_WAIT_L(0); PG8_MMA(0, 1, At, B1); PG8_BAR;
            PG8_LDA(At, 0, 1); PG8_STAGE(PG8_SA(0, 0), a2, voffA);
            PG8_BAR; PG8_WAIT_L(0); PG8_MMA(1, 0, At, B0); PG8_BAR; PG8_SCHED;
            PG8_STAGE(PG8_SB(0, 1), b2 + hstepB, voffB);
            PG8_WAIT_V(6); PG8_BAR; PG8_MMA(1, 1, At, B1); PG8_BAR;
            PG8_LDB(B0, 1, 0); PG8_SCHED; PG8_LDA(At, 1, 0); PG8_STAGE(PG8_SA(0, 1), a2 + hstepA, voffA);
            PG8_WAIT_L(8); PG8_BAR; PG8_WAIT_L(0); PG8_MMA(0, 0, At, B0); PG8_BAR; PG8_SCHED;
            PG8_LDB(B1, 1, 1); PG8_STAGE(PG8_SB(1, 0), b3, voffB);
            PG8_BAR; PG8_WAIT_L(0); PG8_MMA(0, 1, At, B1); PG8_BAR;
            PG8_LDA(At, 1, 1); PG8_STAGE(PG8_SA(1, 0), a3, voffA);
            PG8_BAR; PG8_WAIT_L(0); PG8_MMA(1, 0, At, B0); PG8_BAR; PG8_SCHED;
            PG8_STAGE(PG8_SB(1, 1), b3 + hstepB, voffB);
            PG8_WAIT_V(6); PG8_BAR; PG8_MMA(1, 1, At, B1); PG8_BAR;
            }
        }
        if constexpr (ALIGN_EPI) { if (wr == 0) PG8_BAR; }
        const bool keep = E(acc, cur, wr, wc, fr, fq);
        if (!has_next) break;
        if (!keep) {
#pragma unroll
        for (int a = 0; a < 2; ++a)
#pragma unroll
            for (int b = 0; b < 2; ++b)
#pragma unroll
                for (int m = 0; m < 4; ++m)
#pragma unroll
                    for (int n = 0; n < 2; ++n) acc[a][b][m][n] = (f32x4){0.f, 0.f, 0.f, 0.f};
        }
        cur = nxt; cA = nA; cB = nB; ++ui;
        if constexpr (ALIGN_EPI) { if (wr == 1) PG8_BAR; }
    }
    PG8_WAIT_V(0);
    if constexpr (!ALIGN_EPI) { if (wr == 0) PG8_BAR; }
    PG8_BAR;
#undef PG8_SA
#undef PG8_SB
#undef PG8_STAGE
#undef PG8_LDA
#undef PG8_LDB
#undef PG8_MMA
#undef PG8_WAIT_V
#undef PG8_WAIT_L
#undef PG8_BAR
#undef PG8_SCHED
}
}

struct EpiIn {
    static constexpr bool PERM = true;
    int layer; const float* ss; const float* rmem;
    bf16_t *Q, *Kb, *Vb, *GA, *U, *WB, *XQ, *GX, *MG, *MK, *MV; float* out;
    __device__ __forceinline__ bool operator()(f32x4 (&acc)[2][2][4][2], const pg8::Unit& u, int wr, int wc, int fr, int fq) const {
        int rowt = wr * 64 + fr, cl = wc * 32 + 8 * fq; asm volatile("" : "+v"(rowt), "+v"(cl));
        if (u.z == 1) {
            const int l = u.pn >> 2, q = u.pn & 3; bf16_t* dst = (q < 2 ? MK : MV) + (size_t)l * 512 * 512 + (q & 1) * 256 + cl; float* fo = out + (q < 2 ? O_MKP : O_MVP) + (size_t)l * 512 * 512 + (q & 1) * 256 + cl;
#pragma unroll
            for (int ai = 0; ai < 2; ++ai)
#pragma unroll
                for (int m = 0; m < 4; ++m) { const int row = u.pm * 256 + ai * 128 + rowt + m * 16; const float rs = rmem[row];
#pragma unroll
                    for (int bj = 0; bj < 2; ++bj) { const f32x4 v0 = acc[ai][bj][m][0] * rs, v1 = acc[ai][bj][m][1] * rs;
                        st8(dst + (size_t)row * 512 + bj * 128, v0, v1); *(f32x4*)(fo + (size_t)row * 512 + bj * 128) = v0; *(f32x4*)(fo + (size_t)row * 512 + bj * 128 + 4) = v1; }
                    asm volatile("" ::: "memory"); }
            return false;
        }
        const int pn = u.pn;
        bf16_t* o0; bf16_t* o1; int ld = 512, mode = 0; float sc = 1.f;
        if (pn < 2) { o0 = Q + pn * 256 + cl; o1 = o0 + 128; sc = QSCALE; }
        else if (pn == 2) { o0 = Kb + cl; o1 = Vb + cl; ld = 128; }
        else if (pn < 5) { o0 = GA + (pn - 3) * 256 + cl; o1 = o0 + 128; mode = 1; }
        else if (pn < 9) { o0 = U + (pn - 5) * 128 + cl; o1 = o0; mode = 3; }
        else if (pn < 13) { o0 = WB + (pn - 9) * 128 + cl; o1 = o0; mode = 4; }
        else if (pn < 15) { o0 = XQ + (pn - 13) * 256 + cl; o1 = o0 + 128; }
        else if (pn < 17) { o0 = GX + (pn - 15) * 256 + cl; o1 = o0 + 128; mode = 1; }
        else { o0 = MG + (pn - 17) * 256 + cl; o1 = o0 + 128; ld = 3072; mode = 2; }
        const float* ssr = ss + (size_t)u.pm * 256 + rowt;
#pragma unroll
        for (int ai = 0; ai < 2; ++ai)
#pragma unroll
            for (int m = 0; m < 4; ++m) {
                const int rt = ai * 128 + rowt + m * 16; const size_t roff = ((size_t)u.pm * 256 + rt) * ld; const float rs = rsqrtf(ssr[ai * 128 + m * 16] * (1.0f / 1024.0f) + EPS) * sc;
                f32x4 a00 = acc[ai][0][m][0] * rs, a01 = acc[ai][0][m][1] * rs, a10 = acc[ai][1][m][0] * rs, a11 = acc[ai][1][m][1] * rs;
                if (mode >= 3) {
                    if (mode == 3) { a00 = a00 * a10; a01 = a01 * a11; }
                    else {
#pragma unroll
                        for (int e = 0; e < 4; ++e) { a00[e] = a00[e] * siluf_(a10[e]); a01[e] = a01[e] * siluf_(a11[e]); } }
                    st8_wt(o0 + roff, a00, a01);
                } else {
                    if (mode == 1) {
#pragma unroll
                        for (int e = 0; e < 4; ++e) { a00[e] = siluf_(a00[e]); a01[e] = siluf_(a01[e]); a10[e] = siluf_(a10[e]); a11[e] = siluf_(a11[e]); } }
                    else if (mode == 2) {
#pragma unroll
                        for (int e = 0; e < 4; ++e) { a00[e] = sigmoidf_(a00[e]); a01[e] = sigmoidf_(a01[e]); a10[e] = sigmoidf_(a10[e]); a11[e] = sigmoidf_(a11[e]); } }
                    st8_wt(o0 + roff, a00, a01); st8_wt(o1 + roff, a10, a11);
                }
                asm volatile("" ::: "memory");
            }
        const bool lastp = (u.pm == 31 || u.pm == 63), samp = (u.pm == 64);
        if ((pn == 2 || (pn >= 5 && pn < 9)) && (lastp || samp)) {
            const int bp = u.pm == 63 ? 1 : 0;
#pragma unroll
            for (int ai = 0; ai < 2; ++ai)
#pragma unroll
                for (int m = 0; m < 4; ++m) {
                    const int rt = ai * 128 + rowt + m * 16; const float rs = rsqrtf(ssr[ai * 128 + m * 16] * (1.0f / 1024.0f) + EPS);
                    const f32x4 a00 = acc[ai][0][m][0] * rs, a01 = acc[ai][0][m][1] * rs, a10 = acc[ai][1][m][0] * rs, a11 = acc[ai][1][m][1] * rs;
                    if (pn == 2) {
                        if (samp) { const size_t o = ((size_t)layer * 256 + rt) * 128 + cl; *(f32x4*)(out + O_KS + o) = a00; *(f32x4*)(out + O_KS + o + 4) = a01; *(f32x4*)(out + O_VS + o) = a10; *(f32x4*)(out + O_VS + o + 4) = a11; }
                        else if (ai == 1) { const size_t o = ((size_t)(layer * 2 + bp) * 128 + (rt - 128)) * 128 + cl;
                            *(f32x4*)(out + O_KP + o) = a00; *(f32x4*)(out + O_KP + o + 4) = a01; *(f32x4*)(out + O_VP + o) = a10; *(f32x4*)(out + O_VP + o + 4) = a11; }
                    } else {
                        const int ch = (pn - 5) * 128 + cl; const f32x4 u0 = a00 * a10, u1 = a01 * a11;
                        if (samp) { const int t = rt & 31, b = rt >> 5; if (t >= 30) { float* p = out + O_CS + ((size_t)(layer * 8 + b) * 2 + (t - 30)) * 512 + ch; *(f32x4*)p = u0; *(f32x4*)(p + 4) = u1; } }
                        else if (rt >= 254) { float* p = out + O_CP + ((size_t)(layer * 2 + bp) * 2 + (rt - 254)) * 512 + ch; *(f32x4*)p = u0; *(f32x4*)(p + 4) = u1; }
                    }
                    asm volatile("" ::: "memory");
                }
        }
        return false;
    }
};

struct EpiBranch {
    static constexpr bool PERM = true;
    const bf16_t* MG; bf16_t* ZB;
    __device__ __forceinline__ bool operator()(f32x4 (&acc)[2][2][4][2], const pg8::Unit& u, int wr, int wc, int fr, int fq) const {
        int rowt = wr * 64 + fr, cl = wc * 32 + 8 * fq; asm volatile("" : "+v"(rowt), "+v"(cl));
        const bf16_t* gp = MG + ((size_t)u.pm * 256 + rowt) * 3072 + u.z * 1024 + u.pn * 256 + cl;
        if (u.z < 2) {
#pragma unroll
            for (int ai = 0; ai < 2; ++ai)
#pragma unroll
                for (int m = 0; m < 4; ++m) {
#pragma unroll
                    for (int bj = 0; bj < 2; ++bj) { const bf16_t* g = gp + (size_t)(ai * 128 + m * 16) * 3072 + bj * 128;
                        const u32x4 ga = *(const u32x4*)g, gb = *(const u32x4*)(g + 1024);
#define RAT(x, y) ((x) * __builtin_amdgcn_rcpf(__builtin_fmaxf((y), 1e-30f)))
                        f32x4& v0 = acc[ai][bj][m][0]; f32x4& v1 = acc[ai][bj][m][1];
                        v0[0] *= RAT(bf_lo(ga.x), bf_lo(gb.x)); v0[1] *= RAT(bf_hi(ga.x), bf_hi(gb.x)); v0[2] *= RAT(bf_lo(ga.y), bf_lo(gb.y)); v0[3] *= RAT(bf_hi(ga.y), bf_hi(gb.y));
                        v1[0] *= RAT(bf_lo(ga.z), bf_lo(gb.z)); v1[1] *= RAT(bf_hi(ga.z), bf_hi(gb.z)); v1[2] *= RAT(bf_lo(ga.w), bf_lo(gb.w)); v1[3] *= RAT(bf_hi(ga.w), bf_hi(gb.w));
#undef RAT
                    }
                    asm volatile("" ::: "memory"); }
            return true;
        }
        bf16_t* zp = ZB + ((size_t)u.pm * 256 + rowt) * 1024 + u.pn * 256 + cl;
#pragma unroll
        for (int ai = 0; ai < 2; ++ai)
#pragma unroll
            for (int m = 0; m < 4; ++m) {
#pragma unroll
                for (int bj = 0; bj < 2; ++bj) { const u32x4 gw = *(const u32x4*)(gp + (size_t)(ai * 128 + m * 16) * 3072 + bj * 128);
                    f32x4 v0 = acc[ai][bj][m][0], v1 = acc[ai][bj][m][1];
                    v0[0] *= bf_lo(gw.x); v0[1] *= bf_hi(gw.x); v0[2] *= bf_lo(gw.y); v0[3] *= bf_hi(gw.y);
                    v1[0] *= bf_lo(gw.z); v1[1] *= bf_hi(gw.z); v1[2] *= bf_lo(gw.w); v1[3] *= bf_hi(gw.w);
                    st8(zp + (size_t)(ai * 128 + m * 16) * 1024 + bj * 128, v0, v1); }
                asm volatile("" ::: "memory"); }
        return false;
    }
};

struct EpiOut {
    static constexpr bool PERM = true;
    const float* xold_p; const float* xold_s; float* xnew; bf16_t* XB; float* ssn;
    __device__ __forceinline__ bool operator()(f32x4 (&acc)[2][2][4][2], const pg8::Unit& u, int wr, int wc, int fr, int fq) const {
        int rowt = wr * 64 + fr, cl = wc * 32 + 8 * fq; asm volatile("" : "+v"(rowt), "+v"(cl));
#pragma unroll
        for (int ai = 0; ai < 2; ++ai)
#pragma unroll
            for (int m = 0; m < 4; ++m) { const size_t row = (size_t)u.pm * 256 + ai * 128 + rowt + m * 16;
                const float* src = (row < (size_t)MP) ? xold_p + row * 1024 : xold_s + (row - MP) * 1024; float sq = 0.f;
#pragma unroll
                for (int bj = 0; bj < 2; ++bj) { const int col = u.pn * 256 + bj * 128 + cl;
                    const f32x4 x0 = *(const f32x4*)(src + col) + acc[ai][bj][m][0], x1 = *(const f32x4*)(src + col + 4) + acc[ai][bj][m][1];
                    *(f32x4*)(xnew + row * 1024 + col) = x0; *(f32x4*)(xnew + row * 1024 + col + 4) = x1; st8(XB + row * 1024 + col, x0, x1);
                    sq += (x0[0] * x0[0] + x0[1] * x0[1]) + (x0[2] * x0[2] + x0[3] * x0[3]) + (x1[0] * x1[0] + x1[1] * x1[1]) + (x1[2] * x1[2] + x1[3] * x1[3]); }
                sq += __shfl_xor(sq, 16); sq += __shfl_xor(sq, 32);
                if (fq == 0) atomicAdd(ssn + row, sq); }
        return false;
    }
};

namespace wattn {
constexpr int SLOT = 8192;
constexpr int L_K = 0, L_V = 3 * SLOT, L_WS = 6 * SLOT, L_OST = L_WS + 8 * 256, L_END = L_OST + 8 * 4096;
__device__ __forceinline__ int crow(int r, int hi) { return (r & 3) + 8 * (r >> 2) + 4 * hi; }
struct Ptrs { const bf16_t *Q, *KB, *VB, *CKB, *CVB, *GA; bf16_t* ABX; const float* sink; };

__device__ __forceinline__ void pv(f32x16* o, int vb, bf16x8 pa0, bf16x8 pa1, bf16x8 pa2, bf16x8 pa3) {
#pragma unroll
    for (int d0 = 0; d0 < 2; ++d0) { s16x4 lo[4], hi[4];
#pragma unroll
        for (int ks = 0; ks < 4; ++ks) {
            asm volatile("ds_read_b64_tr_b16 %0,%1 offset:%c2" : "=&v"(lo[ks]) : "v"(vb), "i"(d0 * 4096 + ks * 1024) : "memory");
            asm volatile("ds_read_b64_tr_b16 %0,%1 offset:%c2" : "=&v"(hi[ks]) : "v"(vb), "i"(d0 * 4096 + ks * 1024 + 512) : "memory"); }
        asm volatile("s_waitcnt lgkmcnt(0)" ::: "memory"); __builtin_amdgcn_sched_barrier(0);
#define WPK(k) (bf16x8){lo[k][0], lo[k][1], lo[k][2], lo[k][3], hi[k][0], hi[k][1], hi[k][2], hi[k][3]}
        o[d0] = __builtin_amdgcn_mfma_f32_32x32x16_bf16(pa0, WPK(0), o[d0], 0, 0, 0);
        o[d0] = __builtin_amdgcn_mfma_f32_32x32x16_bf16(pa1, WPK(1), o[d0], 0, 0, 0);
        o[d0] = __builtin_amdgcn_mfma_f32_32x32x16_bf16(pa2, WPK(2), o[d0], 0, 0, 0);
        o[d0] = __builtin_amdgcn_mfma_f32_32x32x16_bf16(pa3, WPK(3), o[d0], 0, 0, 0);
#undef WPK
    }
}

__device__ __forceinline__ void unit(char* shm, const Ptrs& P, int layer, bool sample, int b, int c, int g) {
    int tid = threadIdx.x; asm volatile("" : "+v"(tid));
    const int lane = tid & 63, r32 = lane & 31, hi = lane >> 5; const int wid = __builtin_amdgcn_readfirstlane(tid >> 6);
    const int qrow0 = sample ? MP + 32 * b : b * SEQ + 64 * c;
    const int t0 = sample ? 0 : (c >= 2 ? 0 : 2 - c);
#pragma unroll
    for (int t = 0; t < 3; ++t) {
        if (t >= t0) {
            const bf16_t *kb, *vb; int clampr;
            if (sample && t < 2) { const size_t off = ((size_t)(layer * 8 + b) * 128 + 64 * t) * 128; kb = P.CKB + off; vb = P.CVB + off; clampr = 63; }
            else { const size_t row = sample ? (size_t)qrow0 : (size_t)(qrow0 - 128 + 64 * t); kb = P.KB + row * 128; vb = P.VB + row * 128; clampr = sample ? 31 : 63; }
            const int key = lane < clampr ? lane : clampr;
            const u32x4 kv = *(const u32x4*)(kb + (size_t)key * 128 + g * 64 + wid * 8);
            int vkey = 16 * (wid & 3) + (lane >> 2); vkey = vkey < clampr ? vkey : clampr; const int vd = (wid >> 2) * 32 + (lane & 3) * 8;
            const u32x4 vv = *(const u32x4*)(vb + (size_t)vkey * 128 + g * 64 + vd);
            *(u32x4*)(shm + L_K + t * SLOT + tid * 16) = kv;
            *(u32x4*)(shm + L_V + t * SLOT + tid * 16) = vv;
        }
    }
    __syncthreads();
    const int nrb = sample ? 1 : 2;
    if (wid < 4 * nrb) {
        const int j = sample ? wid : (wid >> 1), rb = sample ? 0 : (wid & 1);
        const int head = 4 * g + j, qi = rb * 32 + r32;
        const bf16_t* qp = P.Q + (size_t)(qrow0 + qi) * 512 + head * 64 + hi * 8;
        bf16x8 qr[4];
#pragma unroll
        for (int d0 = 0; d0 < 4; ++d0) qr[d0] = *(const bf16x8*)(qp + d0 * 16);
        f32x16 p[3][2];
#pragma unroll
        for (int t = 0; t < 3; ++t) {
            if (t >= t0) {
#pragma unroll
                for (int blk = 0; blk < 2; ++blk) { f32x16 a = {};
#pragma unroll
                    for (int d0 = 0; d0 < 4; ++d0) { const bf16x8 kf = *(const bf16x8*)(shm + L_K + t * SLOT + (2 * d0 + hi) * 1024 + (blk * 32 + r32) * 16);
                        a = __builtin_amdgcn_mfma_f32_32x32x16_bf16(kf, qr[d0], a, 0, 0, 0); }
                    p[t][blk] = a; }
            } else {
#pragma unroll
                for (int blk = 0; blk < 2; ++blk)
#pragma unroll
                    for (int r = 0; r < 16; ++r) p[t][blk][r] = -1e30f;
            }
        }
        const float slope2 = __builtin_amdgcn_exp2f(-(float)(head + 1)) * LOG2E;
        const float sink2 = P.sink[layer * 8 + head] * LOG2E;
        float basef = (float)(qi + 128 - 4 * hi); asm volatile("" : "+v"(basef));
        float mx = sink2;
#pragma unroll
        for (int t = 0; t < 3; ++t)
#pragma unroll
            for (int blk = 0; blk < 2; ++blk)
#pragma unroll
                for (int r = 0; r < 16; ++r) {
                    const float kc = (float)(64 * t + 32 * blk + (r & 3) + 8 * (r >> 2));
                    float s = p[t][blk][r] - slope2 * __builtin_fabsf(basef - kc);
                    if (sample && t == 2 && blk == 1) s = -1e30f;
                    if (t < t0) s = -1e30f;
                    p[t][blk][r] = s; mx = __builtin_fmaxf(mx, s);
                }
        { auto rr = __builtin_amdgcn_permlane32_swap(__float_as_uint(mx), __float_as_uint(mx), false, false); mx = __builtin_fmaxf(__uint_as_float(rr[0]), __uint_as_float(rr[1])); }
        float sum = 0.f;
#pragma unroll
        for (int t = 0; t < 3; ++t)
#pragma unroll
            for (int blk = 0; blk < 2; ++blk)
#pragma unroll
                for (int r = 0; r < 16; ++r) { const float e = __builtin_amdgcn_exp2f(p[t][blk][r] - mx); p[t][blk][r] = e; sum += e; }
        { auto rr = __builtin_amdgcn_permlane32_swap(__float_as_uint(sum), __float_as_uint(sum), false, false); sum = __uint_as_float(rr[0]) + __uint_as_float(rr[1]); }
        const float l = sum + __builtin_amdgcn_exp2f(sink2 - mx);
        f32x16 o[2]; o[0] = f32x16{}; o[1] = f32x16{};
        const int vb0 = (int)(unsigned)(uintptr_t)(shm + L_V) + ((lane >> 4) & 1) * 32 + (lane & 3) * 8 + (4 * hi + ((lane & 15) >> 2)) * 64;
#pragma unroll
        for (int t = 0; t < 3; ++t) {
            if (t >= t0) {
                u32x4 w0, w1, w2, w3;
#define PKW(P_, B_) cvt_pk_bf16(P_[B_], P_[B_ + 1])
                w0 = (u32x4){PKW(p[t][0], 0), PKW(p[t][0], 2), PKW(p[t][0], 4), PKW(p[t][0], 6)};
                w1 = (u32x4){PKW(p[t][0], 8), PKW(p[t][0], 10), PKW(p[t][0], 12), PKW(p[t][0], 14)};
                w2 = (u32x4){PKW(p[t][1], 0), PKW(p[t][1], 2), PKW(p[t][1], 4), PKW(p[t][1], 6)};
                w3 = (u32x4){PKW(p[t][1], 8), PKW(p[t][1], 10), PKW(p[t][1], 12), PKW(p[t][1], 14)};
#undef PKW
                pv(o, vb0 + t * SLOT, __builtin_bit_cast(bf16x8, w0), __builtin_bit_cast(bf16x8, w1), __builtin_bit_cast(bf16x8, w2), __builtin_bit_cast(bf16x8, w3));
            }
        }
        float* wsf = (float*)(shm + L_WS) + wid * 64;
        if (hi == 0) wsf[r32] = l;
        asm volatile("s_waitcnt lgkmcnt(0)" ::: "memory");
        bf16_t* stg = (bf16_t*)(shm + L_OST) + wid * 2048;
#pragma unroll
        for (int r = 0; r < 16; ++r) { const int orow = crow(r, hi); const float rl = __builtin_amdgcn_rcpf(wsf[orow]);
#pragma unroll
            for (int d0 = 0; d0 < 2; ++d0) { const float v = o[d0][r] * rl; stg[orow * 64 + d0 * 32 + r32] = (bf16_t)(cvt_pk_bf16(v, v) & 0xffffu); } }
        asm volatile("s_waitcnt lgkmcnt(0)" ::: "memory");
#pragma unroll
        for (int i = 0; i < 4; ++i) { const int row = i * 8 + (lane >> 3), ch = lane & 7;
            const u32x4 ov = *(const u32x4*)(stg + row * 64 + ch * 8);
            const size_t grow = (size_t)(qrow0 + rb * 32 + row);
            const u32x4 gv = *(const u32x4*)(P.GA + grow * 512 + head * 64 + ch * 8);
            u32x4 w;
            w.x = cvt_pk_bf16(bf_lo(ov.x) * bf_lo(gv.x), bf_hi(ov.x) * bf_hi(gv.x)); w.y = cvt_pk_bf16(bf_lo(ov.y) * bf_lo(gv.y), bf_hi(ov.y) * bf_hi(gv.y));
            w.z = cvt_pk_bf16(bf_lo(ov.z) * bf_lo(gv.z), bf_hi(ov.z) * bf_hi(gv.z)); w.w = cvt_pk_bf16(bf_lo(ov.w) * bf_lo(gv.w), bf_hi(ov.w) * bf_hi(gv.w));
            *(u32x4*)(P.ABX + grow * 1536 + head * 64 + ch * 8) = w; }
    }
    __syncthreads();
}
}

namespace xattn {
constexpr int D = 128, NW = 8, QBLK = 32, KVBLK = 64;
constexpr float SCALE = 0.088388347648318440f;
constexpr float THR = 0.f;
constexpr int LDQ = 512, LDK = 512;
constexpr size_t SHM_V = KVBLK * D * 2, SHM_K = KVBLK * D * 2, SHM_ATTN = 2 * SHM_V + 2 * SHM_K + NW * 64 * 4;
constexpr int L_OST2 = (int)SHM_ATTN;
#define KSWZ(row, colB) ((row) * 256 + ((colB) ^ (((row) & 7) << 4)))
#define SBAR() __builtin_amdgcn_sched_barrier(0)
__device__ __forceinline__ int crow(int r, int hi) { return (r & 3) + 8 * (r >> 2) + 4 * hi; }
__device__ __forceinline__ void partialSM(f32x16& p0, f32x16& p1, float& m_reg, float& mn, float& alpha) {
    constexpr float C = SCALE * 1.4426950408889634f;
    float pmax = p0[0];
#pragma unroll
    for (int r = 1; r < 16; ++r) pmax = fmaxf(pmax, p0[r]);
#pragma unroll
    for (int r = 0; r < 16; ++r) pmax = fmaxf(pmax, p1[r]);
    { auto rr = __builtin_amdgcn_permlane32_swap(__float_as_uint(pmax), __float_as_uint(pmax), false, false); pmax = fmaxf(__uint_as_float(rr[0]), __uint_as_float(rr[1])); }
    if (__builtin_expect(__all(pmax - m_reg <= THR / SCALE), 1)) { mn = m_reg; alpha = 1.f; }
    else { mn = fmaxf(m_reg, pmax); alpha = __builtin_amdgcn_exp2f((m_reg - mn) * C); m_reg = mn; }
    const float mnC = -mn * C;
#pragma unroll
    for (int r = 0; r < 16; ++r) p0[r] = fmaf(p0[r], C, mnC);
#pragma unroll
    for (int r = 0; r < 16; ++r) p1[r] = fmaf(p1[r], C, mnC);
#pragma unroll
    for (int r = 0; r < 16; ++r) p0[r] = __builtin_amdgcn_exp2f(p0[r]);
}
__device__ __forceinline__ void finishSM(f32x16& p0, f32x16& p1, float alpha, float& l_reg, bf16x8& pa0, bf16x8& pa1, bf16x8& pa2, bf16x8& pa3) {
#pragma unroll
    for (int r = 0; r < 16; ++r) p1[r] = __builtin_amdgcn_exp2f(p1[r]);
    float ps = 0;
#pragma unroll
    for (int r = 0; r < 16; ++r) ps += p0[r];
#pragma unroll
    for (int r = 0; r < 16; ++r) ps += p1[r];
    { auto rr = __builtin_amdgcn_permlane32_swap(__float_as_uint(ps), __float_as_uint(ps), false, false); ps = __uint_as_float(rr[0]) + __uint_as_float(rr[1]); }
    l_reg = l_reg * alpha + ps;
#define PK4(P, BASE, OUT) do { unsigned a0 = cvt_pk_bf16(P[BASE + 0], P[BASE + 1]), a1 = cvt_pk_bf16(P[BASE + 2], P[BASE + 3]);   \
    unsigned b0 = cvt_pk_bf16(P[BASE + 4], P[BASE + 5]), b1 = cvt_pk_bf16(P[BASE + 6], P[BASE + 7]);                              \
    auto r0 = __builtin_amdgcn_permlane32_swap(a0, b0, false, false); auto r1 = __builtin_amdgcn_permlane32_swap(a1, b1, false, false); \
    u32x4 w = {r0[0], r1[0], r0[1], r1[1]}; OUT = __builtin_bit_cast(bf16x8, w); } while (0)
    PK4(p0, 0, pa0); PK4(p0, 8, pa1); PK4(p1, 0, pa2); PK4(p1, 8, pa3);
#undef PK4
}
__device__ __forceinline__ void qkt(f32x16& p0, f32x16& p1, const char* Ks, const bf16x8* qr, int r32, int hi) {
    p0 = f32x16{}; p1 = f32x16{};
#pragma unroll
    for (int d0 = 0; d0 < 8; ++d0) { const int cb = (d0 * 16 + hi * 8) * 2;
        const bf16x8 b0 = *reinterpret_cast<const bf16x8*>(Ks + KSWZ(r32, cb));
        const bf16x8 b1 = *reinterpret_cast<const bf16x8*>(Ks + KSWZ(32 + r32, cb));
        p0 = __builtin_amdgcn_mfma_f32_32x32x16_bf16(b0, qr[d0], p0, 0, 0, 0);
        p1 = __builtin_amdgcn_mfma_f32_32x32x16_bf16(b1, qr[d0], p1, 0, 0, 0); }
}
__device__ __forceinline__ int v_st(int k, int c) { const int kk = (k & ~0xC) | ((k & 4) << 1) | ((k & 8) >> 1); return ((kk >> 3) * 4 + (c >> 5)) * 512 + ((kk & 7) * 32 + (c & 31)) * 2; }
__device__ __forceinline__ int v_rd_base(int lane) { return ((lane & 3) << 3) | (((lane >> 2) & 3) << 6) | (((lane >> 4) & 1) << 5) | (((lane >> 5) & 1) << 8); }
constexpr int v_rd_off(int d0, int ks, int half) { return d0 * 512 + ks * 4096 + half * 2048; }
template <int OFF> __device__ __forceinline__ s16x4 tr_read(int vb) { s16x4 r; asm volatile("ds_read_b64_tr_b16 %0, %1 offset:%2" : "=&v"(r) : "v"(vb), "i"(OFF) : "memory"); return r; }
template <int D0> __device__ __forceinline__ void pv_one(f32x16& od, int vb, bf16x8 pa0, bf16x8 pa1, bf16x8 pa2, bf16x8 pa3) {
    const s16x4 l0 = tr_read<v_rd_off(D0, 0, 0)>(vb), h0 = tr_read<v_rd_off(D0, 0, 1)>(vb), l1 = tr_read<v_rd_off(D0, 1, 0)>(vb), h1 = tr_read<v_rd_off(D0, 1, 1)>(vb);
    const s16x4 l2 = tr_read<v_rd_off(D0, 2, 0)>(vb), h2 = tr_read<v_rd_off(D0, 2, 1)>(vb), l3 = tr_read<v_rd_off(D0, 3, 0)>(vb), h3 = tr_read<v_rd_off(D0, 3, 1)>(vb);
    asm volatile("s_waitcnt lgkmcnt(0)" ::: "memory"); SBAR();
#define XPK(L, H) (bf16x8){L[0], L[1], L[2], L[3], H[0], H[1], H[2], H[3]}
    od = __builtin_amdgcn_mfma_f32_32x32x16_bf16(pa0, XPK(l0, h0), od, 0, 0, 0);
    od = __builtin_amdgcn_mfma_f32_32x32x16_bf16(pa1, XPK(l1, h1), od, 0, 0, 0);
    od = __builtin_amdgcn_mfma_f32_32x32x16_bf16(pa2, XPK(l2, h2), od, 0, 0, 0);
    od = __builtin_amdgcn_mfma_f32_32x32x16_bf16(pa3, XPK(l3, h3), od, 0, 0, 0);
#undef XPK
}
__device__ __forceinline__ void pv_d0(f32x16* o, int vb, bf16x8 pa0, bf16x8 pa1, bf16x8 pa2, bf16x8 pa3) {
    pv_one<0>(o[0], vb, pa0, pa1, pa2, pa3); pv_one<1>(o[1], vb, pa0, pa1, pa2, pa3); pv_one<2>(o[2], vb, pa0, pa1, pa2, pa3); pv_one<3>(o[3], vb, pa0, pa1, pa2, pa3);
}
__device__ __forceinline__ void body(const bf16_t* __restrict__ Qb, const bf16_t* __restrict__ Kh, const bf16_t* __restrict__ Vh, const bf16_t* __restrict__ Gb, bf16_t* __restrict__ Ob, int nvw, char* lds) {
    constexpr int seq = 256;
    int tid = threadIdx.x; asm volatile("" : "+v"(tid));
    const int wid = __builtin_amdgcn_readfirstlane(tid >> 6), lane = tid & 63, r32 = lane & 31, hi = lane >> 5;
    const int widq = wid < nvw ? wid : 0;
    char* V_lds = lds; char* K_lds = lds + 2 * SHM_V;
    float* ws = (float*)(lds + 2 * SHM_V + 2 * SHM_K) + wid * 64; float* li_l = ws; float* al_l = ws + 32;
    float m_reg = -1e30f, l_reg = 0; f32x16 o[4] = {}; bf16x8 qr[8];
    const bf16_t* Qw = Qb + (long)(widq * QBLK + r32) * LDQ + hi * 8;
#pragma unroll
    for (int d0 = 0; d0 < 8; ++d0) qr[d0] = *reinterpret_cast<const bf16x8*>(Qw + d0 * 16);
    const int sr = tid >> 4, sc = (tid & 15) * 8, vst0 = v_st(sr, sc), vst1 = v_st(32 + sr, sc);
    const int vb0 = (int)(unsigned)(uintptr_t)V_lds + v_rd_base(lane);
    struct { bf16x8 vs0, vs1, ks0, ks1; } sr_[2];
#define SLOAD(i, k0) do { sr_[i].vs0 = *reinterpret_cast<const bf16x8*>(&Vh[(long)((k0) + sr) * LDK + sc]); sr_[i].vs1 = *reinterpret_cast<const bf16x8*>(&Vh[(long)((k0) + 32 + sr) * LDK + sc]); \
    sr_[i].ks0 = *reinterpret_cast<const bf16x8*>(&Kh[(long)((k0) + sr) * LDK + sc]); sr_[i].ks1 = *reinterpret_cast<const bf16x8*>(&Kh[(long)((k0) + 32 + sr) * LDK + sc]); } while (0)
#define SWRITE(b, i) do { *(bf16x8*)(V_lds + (b) * SHM_V + vst0) = sr_[i].vs0;          \
    *(bf16x8*)(V_lds + (b) * SHM_V + vst1) = sr_[i].vs1; const int kc = sc * 2;               \
    *(bf16x8*)(K_lds + (b) * SHM_K + KSWZ(sr, kc)) = sr_[i].ks0;                       \
    *(bf16x8*)(K_lds + (b) * SHM_K + KSWZ(32 + sr, kc)) = sr_[i].ks1; } while (0)
#define SWAIT() asm volatile("s_waitcnt vmcnt(4)" ::: "memory")
#define RESC(a) do { if (__any((a) < 1.f)) { if (hi == 0) al_l[r32] = (a); asm volatile("s_waitcnt lgkmcnt(0)" ::: "memory"); \
    _Pragma("unroll") for (int d = 0; d < 4; ++d) _Pragma("unroll") for (int r = 0; r < 16; ++r) o[d][r] *= al_l[crow(r, hi)]; } } while (0)
    f32x16 pA0, pA1, pB0, pB1; float mnA, mnB, alA, alB; bf16x8 pa0, pa1, pa2, pa3; constexpr int NT = seq / KVBLK;
    constexpr int SE = 0, SO = 1;
    SLOAD(SE, 0); asm volatile("s_waitcnt vmcnt(0)" ::: "memory"); SWRITE(0, SE); __syncthreads();
    qkt(pA0, pA1, K_lds, qr, r32, hi); partialSM(pA0, pA1, m_reg, mnA, alA);
    SLOAD(SO, KVBLK); if (2 < NT) SLOAD(SE, 2 * KVBLK);
    SWAIT(); SWRITE(1, SO); __syncthreads();
#pragma unroll 1
    for (int j = 1; j + 1 < NT; j += 2) {
        SBAR(); qkt(pB0, pB1, K_lds + SHM_K, qr, r32, hi);
        finishSM(pA0, pA1, alA, l_reg, pa0, pa1, pa2, pa3); SBAR();
        SLOAD(SO, (j + 2) * KVBLK); SBAR();
        pv_d0(o, vb0, pa0, pa1, pa2, pa3); partialSM(pB0, pB1, m_reg, mnB, alB);
        __syncthreads(); SWAIT(); SWRITE(0, SE);
        RESC(alB); __syncthreads();
        SBAR(); qkt(pA0, pA1, K_lds, qr, r32, hi);
        finishSM(pB0, pB1, alB, l_reg, pa0, pa1, pa2, pa3); SBAR();
        if (j + 3 < NT) SLOAD(SE, (j + 3) * KVBLK); SBAR();
        pv_d0(o, vb0 + (int)SHM_V, pa0, pa1, pa2, pa3); partialSM(pA0, pA1, m_reg, mnA, alA);
        __syncthreads(); SWAIT(); SWRITE(1, SO);
        RESC(alA); __syncthreads();
    }
    SBAR(); qkt(pB0, pB1, K_lds + SHM_K, qr, r32, hi);
    finishSM(pA0, pA1, alA, l_reg, pa0, pa1, pa2, pa3); SBAR();
    pv_d0(o, vb0, pa0, pa1, pa2, pa3); partialSM(pB0, pB1, m_reg, mnB, alB);
    __syncthreads(); RESC(alB);
    finishSM(pB0, pB1, alB, l_reg, pa0, pa1, pa2, pa3); SBAR();
    pv_d0(o, vb0 + (int)SHM_V, pa0, pa1, pa2, pa3);
    if (hi == 0) li_l[r32] = l_reg; asm volatile("s_waitcnt lgkmcnt(0)" ::: "memory");
    bf16_t* stg = (bf16_t*)(wid < 4 ? K_lds + wid * 8192 : lds + L_OST2 + (wid - 4) * 8192);
#pragma unroll
    for (int r = 0; r < 16; ++r) { const int orow = crow(r, hi); const float rl = __builtin_amdgcn_rcpf(li_l[orow]);
#pragma unroll
        for (int d0 = 0; d0 < 4; ++d0) { const float v = o[d0][r] * rl; stg[orow * 128 + d0 * 32 + r32] = (bf16_t)(cvt_pk_bf16(v, v) & 0xffffu); } }
    asm volatile("s_waitcnt lgkmcnt(0)" ::: "memory");
    if (wid < nvw) {
#pragma unroll
        for (int i = 0; i < 8; ++i) { const int row = i * 4 + (lane >> 4), ch = lane & 15;
            const u32x4 ov = *(const u32x4*)(stg + row * 128 + ch * 8);
            const long grow = (long)(wid * QBLK + row);
            const u32x4 gv = *(const u32x4*)(Gb + grow * 512 + ch * 8);
            u32x4 w;
            w.x = cvt_pk_bf16(bf_lo(ov.x) * bf_lo(gv.x), bf_hi(ov.x) * bf_hi(gv.x)); w.y = cvt_pk_bf16(bf_lo(ov.y) * bf_lo(gv.y), bf_hi(ov.y) * bf_hi(gv.y));
            w.z = cvt_pk_bf16(bf_lo(ov.z) * bf_lo(gv.z), bf_hi(ov.z) * bf_hi(gv.z)); w.w = cvt_pk_bf16(bf_lo(ov.w) * bf_lo(gv.w), bf_hi(ov.w) * bf_hi(gv.w));
            *(u32x4*)(Ob + grow * 1536 + ch * 8) = w; }
    }
    __syncthreads();
#undef SLOAD
#undef SWRITE
#undef SWAIT
#undef RESC
}
#undef KSWZ
#undef SBAR
}

typedef GAS unsigned gu32;
#define RLX_AGENT __ATOMIC_RELAXED, __HIP_MEMORY_SCOPE_AGENT
#define XB_TMO      128
#define XB_XCNT(j)  (256  + 64 * (j))
#define XB_XSUB(j)  (1280 + 64 * (j))
#define XB_XGEN(j)  (2304 + 64 * (j))
#define XB_TOP      3328
#define XB_TOPGEN   3392
#define XCD_BAR_WORDS 3456
#define XB_SPIN_CAP (1u << 18)
__device__ __forceinline__ unsigned xb_ld(unsigned* p)              { return __hip_atomic_load(p, __ATOMIC_RELAXED, __HIP_MEMORY_SCOPE_AGENT); }
__device__ __forceinline__ unsigned xb_add(unsigned* p, unsigned v) { return __hip_atomic_fetch_add(p, v, __ATOMIC_RELAXED, __HIP_MEMORY_SCOPE_AGENT); }
__device__ __forceinline__ unsigned xb_xcc_id() { return (unsigned)__builtin_amdgcn_s_getreg((3 << 11) | 20) & 0xFu; }
#define XB_SPIN(cond, bar) do { unsigned _sp = 0; while (cond) { __builtin_amdgcn_s_sleep(1); \
    if ((++_sp & 255u) == 0u) { if (xb_ld(&(bar)[XB_TMO])) break; if (_sp > XB_SPIN_CAP) { atomicAdd(&(bar)[XB_TMO], 1u); break; } } } } while (0)
struct XcdBarrier { unsigned* bar; unsigned x; volatile LAS unsigned* st; };
__device__ __forceinline__ XcdBarrier xcd_barrier_post(unsigned* bar, volatile LAS unsigned* st) {
    XcdBarrier b; b.bar = bar; b.x = xb_xcc_id(); b.st = st;
    if (threadIdx.x == 0) (void)xb_add(&bar[XB_XCNT(b.x)], 1u);
    return b;
}
__device__ __forceinline__ void xcd_barrier_complete(unsigned* bar, unsigned x, unsigned& nloc, unsigned& nx) {
    const unsigned G = gridDim.x * gridDim.y * gridDim.z;
    unsigned sum, cnt, mine, sp = 0u;
    for (;;) {
        sum = 0u; cnt = 0u; mine = 0u;
#pragma unroll
        for (unsigned j = 0; j < 16; ++j) { const unsigned c = xb_ld(&bar[XB_XCNT(j)]); sum += c; cnt += (c > 0u) ? 1u : 0u; mine = (j == x) ? c : mine; }
        if (sum == G) break;
        __builtin_amdgcn_s_sleep(1);
        if ((++sp & 255u) == 0u) { if (xb_ld(&bar[XB_TMO])) break; if (sp > XB_SPIN_CAP) { atomicAdd(&bar[XB_TMO], 1u); break; } }
    }
    nloc = mine > 0u ? mine : 1u; nx = cnt > 0u ? cnt : 1u;
}
__device__ __forceinline__ void xcd_barrier(const XcdBarrier& b) {
    asm volatile("s_waitcnt vmcnt(0)" ::: "memory");
    __syncthreads();
    if (threadIdx.x == 0) {
        unsigned* bar = b.bar;
        __builtin_amdgcn_s_waitcnt(0);
        unsigned nloc = b.st[0], nx = b.st[1];
        if (nloc == 0u) { xcd_barrier_complete(bar, b.x, nloc, nx); b.st[0] = nloc; b.st[1] = nx; }
        const unsigned old = xb_add(&bar[XB_XSUB(b.x)], 1u);
        const unsigned gen = old / nloc;
        if (old + 1u == (gen + 1u) * nloc) {
            __builtin_amdgcn_fence(__ATOMIC_RELEASE, "agent");
            asm volatile("s_waitcnt vmcnt(0)" ::: "memory");
            const unsigned og = xb_add(&bar[XB_TOP], 1u);
            const unsigned tg = og / nx;
            if (og + 1u == (tg + 1u) * nx) xb_add(&bar[XB_TOPGEN], 1u);
            else XB_SPIN(xb_ld(&bar[XB_TOPGEN]) == tg, bar);
            __builtin_amdgcn_fence(__ATOMIC_ACQUIRE, "agent");
            xb_add(&bar[XB_XGEN(b.x)], 1u);
            asm volatile("s_waitcnt vmcnt(0)" ::: "memory");
        } else {
            XB_SPIN(xb_ld(&bar[XB_XGEN(b.x)]) == gen, bar);
            __builtin_amdgcn_fence(__ATOMIC_ACQUIRE, "agent");
            asm volatile("s_waitcnt vmcnt(0)" ::: "memory");
        }
    }
    __syncthreads();
}

__device__ __forceinline__ void s_barrier_n(unsigned* cnt, unsigned target, unsigned* tmo) {
    asm volatile("s_waitcnt vmcnt(0)" ::: "memory");
    __syncthreads();
    if (threadIdx.x == 0) {
        __builtin_amdgcn_fence(__ATOMIC_RELEASE, "agent");
        asm volatile("s_waitcnt vmcnt(0)" ::: "memory");
        (void)xb_add(cnt, 1u);
        unsigned sp = 0;
        while (xb_ld(cnt) < target) { __builtin_amdgcn_s_sleep(1); if (++sp > (1u << 22)) { atomicAdd(tmo, 1u); break; } }
        __builtin_amdgcn_fence(__ATOMIC_ACQUIRE, "agent");
        asm volatile("s_waitcnt vmcnt(0)" ::: "memory");
    }
    __syncthreads();
}

constexpr int NWAVES = 8;
constexpr int N_PHASES = 2 + 4 * DEPTH;
constexpr int CW_BAR = 4096;
constexpr int CW_SBAR = 8192;
constexpr int NS = 8;
constexpr int RING_BYTES = 131072, LDSCTL_OFF = RING_BYTES, MISC_OFF = LDSCTL_OFF + 320, LDS_BYTES = 147456;
static_assert(wattn::L_END <= RING_BYTES && xattn::L_OST2 + 4 * 8192 <= RING_BYTES, "phase scratch inside the ring");

struct Args { const void* in[21]; float* out; unsigned char* ws; int ph_lo, ph_hi; };

__device__ __forceinline__ float wave_sum(float v) {
#pragma unroll
    for (int o = 1; o < 64; o <<= 1) v += __shfl_xor(v, o);
    return v;
}
__device__ __forceinline__ void tr_item64(const float* W, int ldw, int k0, int ncol0, const float* gk, bf16_t* WT, int ldd, int drow0, int dcol0, int lane) {
    const int n4 = lane & 15, kq = lane >> 4;
    const float* src = W + (size_t)(k0 + 16 * kq) * ldw + ncol0 + 4 * n4;
    f32x4 v[16];
#pragma unroll
    for (int i = 0; i < 16; ++i) v[i] = *(const f32x4*)(src + (size_t)i * ldw);
    if (gk) { const f32x4* gp = (const f32x4*)(gk + k0 + 16 * kq);
#pragma unroll
        for (int q = 0; q < 4; ++q) { const f32x4 gq = gp[q];
#pragma unroll
            for (int e = 0; e < 4; ++e) v[4 * q + e] = v[4 * q + e] * gq[e]; } }
    bf16_t* d = WT + (size_t)(drow0 + 4 * n4) * ldd + dcol0 + k0 + 16 * kq;
#pragma unroll
    for (int j = 0; j < 4; ++j) {
        u32x4 lo, hi;
        lo.x = cvt_pk_bf16(v[0][j], v[1][j]); lo.y = cvt_pk_bf16(v[2][j], v[3][j]); lo.z = cvt_pk_bf16(v[4][j], v[5][j]); lo.w = cvt_pk_bf16(v[6][j], v[7][j]);
        hi.x = cvt_pk_bf16(v[8][j], v[9][j]); hi.y = cvt_pk_bf16(v[10][j], v[11][j]); hi.z = cvt_pk_bf16(v[12][j], v[13][j]); hi.w = cvt_pk_bf16(v[14][j], v[15][j]);
        *(u32x4*)(d + (size_t)j * ldd) = lo; *(u32x4*)(d + (size_t)j * ldd + 8) = hi; }
}
__device__ __forceinline__ int in_srcmap(int n) {
    if (n < 1280) return n;
    if (n < 2304) { const int i = (n - 1280) >> 8, w = (n - 1280) & 255; return w < 128 ? 1792 + 128 * i + w : 2304 + 128 * i + (w - 128); }
    if (n < 3328) { const int i = (n - 2304) >> 8, w = (n - 2304) & 255; return w < 128 ? 1280 + 128 * i + w : 2816 + 128 * i + (w - 128); }
    return n;
}
__device__ __forceinline__ float row_to_bf16(const float* xrow, bf16_t* orow, int lane) {
    const f32x4* xr = (const f32x4*)xrow + lane; f32x4 v[4]; float s = 0.f;
#pragma unroll
    for (int j = 0; j < 4; ++j) { v[j] = xr[64 * j]; s += (v[j][0] * v[j][0] + v[j][1] * v[j][1]) + (v[j][2] * v[j][2] + v[j][3] * v[j][3]); }
    u32x2* o8 = (u32x2*)orow + lane;
#pragma unroll
    for (int j = 0; j < 4; ++j) { u32x2 w; w.x = cvt_pk_bf16(v[j][0], v[j][1]); w.y = cvt_pk_bf16(v[j][2], v[j][3]); o8[64 * j] = w; }
    return wave_sum(s);
}

__global__ void __launch_bounds__(NWAVES * 64, 2) fwd_kernel(Args args) {
    extern __shared__ __attribute__((aligned(16))) unsigned char lds[];
    LAS unsigned char* ldsl = (LAS unsigned char*)lds;
    volatile LAS unsigned* MISC = (volatile LAS unsigned*)(ldsl + MISC_OFF);
    const int tid = threadIdx.x, lane = tid & 63, wave = __builtin_amdgcn_readfirstlane(tid >> 6);
    const int G = gridDim.x; const int bx = blockIdx.x; const int vcu = (G % 8 == 0) ? (bx % 8) * (G / 8) + bx / 8 : bx;
    unsigned char* ws = args.ws; float* out = args.out;
    unsigned* ctl = (unsigned*)(ws + WS_CTL);
    for (int u = tid; u < (LDS_BYTES - LDSCTL_OFF) / 4; u += NWAVES * 64) ((LAS unsigned*)(ldsl + LDSCTL_OFF))[u] = 0u;
    __syncthreads();
    XcdBarrier bar = xcd_barrier_post(ctl + CW_BAR, MISC + 8);
    const int lo = args.ph_lo, hi = args.ph_hi;
#define IN(k) (lo <= (k) && (k) < hi)
#define SEAM(k) do { if (IN(k) && IN((k) + 1)) { xcd_barrier(bar); if (PROBE_DUP & 32) xcd_barrier(bar); } } while (0)

    const float* x_prompt = (const float*)args.in[0]; const float* x_sample = (const float*)args.in[1];
    const float* cache_attn_k = (const float*)args.in[2]; const float* cache_attn_v = (const float*)args.in[3]; const float* cache_conv = (const float*)args.in[4];
    const float* cache_mem_k = (const float*)args.in[5]; const float* cache_mem_v = (const float*)args.in[6]; const float* mem_prompt = (const float*)args.in[7];
    const float* norm_g = (const float*)args.in[8]; const float* w_in = (const float*)args.in[9]; const float* attn_sink = (const float*)args.in[10];
    const float* w_pa = (const float*)args.in[11]; const float* conv_w = (const float*)args.in[12]; const float* conv_b = (const float*)args.in[13];
    const float* w_pb = (const float*)args.in[14]; const float* mem_norm_g = (const float*)args.in[15]; const float* w_mk = (const float*)args.in[16];
    const float* w_mv = (const float*)args.in[17]; const float* w_px = (const float*)args.in[18]; const float* w_out = (const float*)args.in[19]; const float* final_g = (const float*)args.in[20];

    float* SS = (float*)(ws + WS_SS);
    bf16_t* WIN = (bf16_t*)(ws + WS_WIN); bf16_t* WP = (bf16_t*)(ws + WS_WP); bf16_t* WO = (bf16_t*)(ws + WS_WO); bf16_t* WM = (bf16_t*)(ws + WS_WM);
    bf16_t* XB = (bf16_t*)(ws + WS_XB); bf16_t* MEMB = (bf16_t*)(ws + WS_MEMB); float* RMEM = (float*)(ws + WS_RMEM);
    bf16_t* CKB = (bf16_t*)(ws + WS_CKB); bf16_t* CVB = (bf16_t*)(ws + WS_CVB); bf16_t* CMK = (bf16_t*)(ws + WS_CMK); bf16_t* CMV = (bf16_t*)(ws + WS_CMV);
    bf16_t* MK = (bf16_t*)(ws + WS_MK); bf16_t* MV = (bf16_t*)(ws + WS_MV); bf16_t* MG = (bf16_t*)(ws + WS_MG); bf16_t* ABX = (bf16_t*)(ws + WS_ABX);
    bf16_t* Qb = (bf16_t*)(ws + WS_Q); bf16_t* GA = (bf16_t*)(ws + WS_GA); bf16_t* Ub = (bf16_t*)(ws + WS_U); bf16_t* WBb = (bf16_t*)(ws + WS_WB);
    bf16_t* XQ = (bf16_t*)(ws + WS_XQ); bf16_t* GX = (bf16_t*)(ws + WS_GX); bf16_t* Kb = (bf16_t*)(ws + WS_K); bf16_t* Vb = (bf16_t*)(ws + WS_V);
    float* ZF = (float*)(ws + WS_ZF); bf16_t* ZB = (bf16_t*)(ws + WS_ZB);
    const int gw = vcu * NWAVES + wave, NGW = G * NWAVES;

#ifndef NO_P0
    for (int rep_ = 0; rep_ < ((PROBE_DUP & 16) ? 2 : 1); ++rep_)
    if (IN(0)) {
        constexpr int I_IN = 16 * 116, I_P = 3 * 8 * 16, I_O = 16 * 16, I_M = 2 * 16 * 8, I_L = I_IN + I_P + I_O + I_M;
        for (int it = gw; it < DEPTH * I_L; it += NGW) {
            const int l = it / I_L; int r = it - l * I_L;
            if (r < I_IN) { const int kb = r / 116, nb = r - kb * 116; tr_item64(w_in + (size_t)l * 1024 * NIN, NIN, 64 * kb, in_srcmap(64 * nb), norm_g + l * 1024, WIN + (size_t)l * NIN * 1024, 1024, 64 * nb, 0, lane); continue; }
            r -= I_IN;
            if (r < I_P) { const int br = r / 128, q = r - br * 128, kb = q >> 4, nb = q & 15; const float* W = (br == 0 ? w_pa : br == 1 ? w_pb : w_px) + (size_t)l * 512 * 1024;
                tr_item64(W, 1024, 64 * kb, 64 * nb, nullptr, WP + (size_t)l * 1024 * 1536, 1536, 64 * nb, br * 512, lane); continue; }
            r -= I_P;
            if (r < I_O) { const int kb = r >> 4, nb = r & 15; tr_item64(w_out + (size_t)l * 1024 * 1024, 1024, 64 * kb, 64 * nb, nullptr, WO + (size_t)l * 1024 * 1024, 1024, 64 * nb, 0, lane); continue; }
            r -= I_O;
            { const int kv = r >> 7, q = r & 127, kb = q >> 3, nb = q & 7; const float* W = (kv == 0 ? w_mk : w_mv) + (size_t)l * 1024 * 512;
              tr_item64(W, 512, 64 * kb, 64 * nb, mem_norm_g + l * 1024, WM + (size_t)l * 1024 * 1024, 1024, kv * 512 + 64 * nb, 0, lane); }
        }
        for (int m = gw; m < MT; m += NGW) { const float* xr = m < MP ? x_prompt + (size_t)m * 1024 : x_sample + (size_t)(m - MP) * 1024;
            const float s = row_to_bf16(xr, XB + (size_t)m * 1024, lane); if (lane == 0) SS[m] = s; }
        for (int m = gw; m < MEMROWS; m += NGW) { const float s = row_to_bf16(mem_prompt + (size_t)m * 1024, MEMB + (size_t)m * 1024, lane); if (lane == 0) RMEM[m] = rsqrtf(s * (1.0f / 1024.0f) + EPS); }
        {
            const size_t n1 = (size_t)DEPTH * DECB * 128 * 128 / 8, n2 = (size_t)DEPTH * DECB * 256 * 512 / 8, ntot = 2 * n1 + 2 * n2;
            for (size_t i = (size_t)vcu * 512 + tid; i < ntot; i += (size_t)G * 512) {
                const float* s; bf16_t* d; size_t j = i;
                if (j < n1) { s = cache_attn_k; d = CKB; } else if ((j -= n1) < n1) { s = cache_attn_v; d = CVB; } else if ((j -= n1) < n2) { s = cache_mem_k; d = CMK; } else { j -= n2; s = cache_mem_v; d = CMV; }
                const f32x4 a = *(const f32x4*)(s + j * 8), b = *(const f32x4*)(s + j * 8 + 4); st8(d + j * 8, a, b);
            }
        }
    }
#endif
    SEAM(0);

    for (int layer = 0; layer < DEPTH; ++layer) {
        const int pbase = 1 + 4 * layer;
#ifndef NO_A
        for (int rep_ = 0; rep_ < ((PROBE_DUP & 1) ? 2 : 1); ++rep_)
        if (IN(pbase)) {
            pg8::Gemm g{(const char*)XB, (const char*)(WIN + (size_t)layer * NIN * 1024), 1024, 1024, 1024, (long)((const char*)MEMB - (const char*)XB), (long)((const char*)WM - (const char*)(WIN + (size_t)layer * NIN * 1024))};
            EpiIn E{layer, SS + (size_t)layer * MT, RMEM, Qb, Kb, Vb, GA, Ub, WBb, XQ, GX, MG, MK, MV, out};
            if (bx >= G - NS) {
                const int si = bx - (G - NS);
                if (layer > 0) {
                    { pg8::Gemm gc{(const char*)ABX, (const char*)(WP + (size_t)(layer - 1) * 1024 * 1536), 1536, 1536, 512, 1024, 1024};
                      pg8::SchedS Sc{64, si, NS, 4, 3}; EpiBranch Ec{MG, ZB};
                      pg8::gemm_phase<EpiBranch, pg8::SchedS, true, true>(ldsl, gc, Sc, Ec); }
                    s_barrier_n(ctl + CW_SBAR, (unsigned)(NS * (2 * layer - 1)), ctl + CW_BAR + XB_TMO);
                    { pg8::Gemm gd{(const char*)ZB, (const char*)(WO + (size_t)(layer - 1) * 1024 * 1024), 1024, 1024, 1024, 0, 0};
                      pg8::SchedS Sd{64, si, NS, 4, 1};
                      EpiOut Ed{out + O_YP, layer == 1 ? x_sample : out + O_YS, out, XB, SS + (size_t)layer * MT};
                      pg8::gemm_phase<EpiOut, pg8::SchedS, true, true>(ldsl, gd, Sd, Ed); }
                    s_barrier_n(ctl + CW_SBAR, (unsigned)(NS * (2 * layer)), ctl + CW_BAR + XB_TMO);
                }
                pg8::SchedS Sa{64, si, NS, NIN / 256, 1};
                pg8::gemm_phase<EpiIn, pg8::SchedS, true, true>(ldsl, g, Sa, E);
            } else {
                pg8::Sched S; S.init(MP, NIN, G - NS, bx, 1, layer == 0 ? 32 : 0);
                pg8::gemm_phase<EpiIn, pg8::Sched, true, true>(ldsl, g, S, E);
            }
        }
#endif
        SEAM(pbase);
        for (int rep_ = 0; rep_ < ((PROBE_DUP & 2) ? 2 : 1); ++rep_)
        if (IN(pbase + 1)) {
            const wattn::Ptrs WPt{Qb, Kb, Vb, CKB, CVB, GA, ABX, attn_sink};
#ifndef NO_W
            for (int ui = vcu; ui < 528; ui += G) {
                if (ui < 512) { const int g_ = ui & 1, bc = ui >> 1; wattn::unit((char*)lds, WPt, layer, false, bc >> 7, bc & 127, g_); }
                else { const int s = ui - 512; wattn::unit((char*)lds, WPt, layer, true, s >> 1, 0, s & 1); }
            }
#endif
#ifndef NO_X
            for (int ui = vcu; ui < 288; ui += G) {
                if (ui < 256) { const int h = ui & 3, rest = ui >> 2, qb = rest & 31, b = rest >> 5; const size_t row0 = (size_t)b * SEQ + (size_t)qb * 256;
                    xattn::body(XQ + row0 * 512 + h * 128, MK + ((size_t)layer * 512 + b * 256) * 512 + h * 128, MV + ((size_t)layer * 512 + b * 256) * 512 + h * 128,
                                GX + row0 * 512 + h * 128, ABX + row0 * 1536 + 1024 + h * 128, 8, (char*)lds); }
                else { const int s = ui - 256, h = s & 3, b = s >> 2; const size_t row0 = (size_t)MP + 32 * b; const size_t co = ((size_t)(layer * DECB + b) * 256) * 512 + h * 128;
                    xattn::body(XQ + row0 * 512 + h * 128, CMK + co, CMV + co, GX + row0 * 512 + h * 128, ABX + row0 * 1536 + 1024 + h * 128, 1, (char*)lds); }
            }
#endif
#ifndef NO_CV
            for (int it = vcu; it < MT / 64; it += G) {
                const int ch = lane * 8; const int row0 = it * 64 + wave * 8;
                const float* cw = conv_w + (size_t)layer * 3 * 512 + ch; const float* cb = conv_b + (size_t)layer * 512 + ch;
                float w0[8], w1[8], w2[8], bb_[8], um2[8], um1[8];
#pragma unroll
                for (int e = 0; e < 8; ++e) { w0[e] = cw[e]; w1[e] = cw[512 + e]; w2[e] = cw[1024 + e]; bb_[e] = cb[e]; um2[e] = 0.f; um1[e] = 0.f; }
                if (row0 < MP) { const int pos = row0 & (SEQ - 1);
                    if (pos >= 2) { const u32x4 a = *(const u32x4*)(Ub + (size_t)(row0 - 2) * 512 + ch), b = *(const u32x4*)(Ub + (size_t)(row0 - 1) * 512 + ch);
                        um2[0] = bf_lo(a.x); um2[1] = bf_hi(a.x); um2[2] = bf_lo(a.y); um2[3] = bf_hi(a.y); um2[4] = bf_lo(a.z); um2[5] = bf_hi(a.z); um2[6] = bf_lo(a.w); um2[7] = bf_hi(a.w);
                        um1[0] = bf_lo(b.x); um1[1] = bf_hi(b.x); um1[2] = bf_lo(b.y); um1[3] = bf_hi(b.y); um1[4] = bf_lo(b.z); um1[5] = bf_hi(b.z); um1[6] = bf_lo(b.w); um1[7] = bf_hi(b.w); }
                } else { const int rs = row0 - MP, t = rs & 31, b = rs >> 5;
                    if (t >= 2) { const u32x4 a = *(const u32x4*)(Ub + (size_t)(row0 - 2) * 512 + ch), b2 = *(const u32x4*)(Ub + (size_t)(row0 - 1) * 512 + ch);
                        um2[0] = bf_lo(a.x); um2[1] = bf_hi(a.x); um2[2] = bf_lo(a.y); um2[3] = bf_hi(a.y); um2[4] = bf_lo(a.z); um2[5] = bf_hi(a.z); um2[6] = bf_lo(a.w); um2[7] = bf_hi(a.w);
                        um1[0] = bf_lo(b2.x); um1[1] = bf_hi(b2.x); um1[2] = bf_lo(b2.y); um1[3] = bf_hi(b2.y); um1[4] = bf_lo(b2.z); um1[5] = bf_hi(b2.z); um1[6] = bf_lo(b2.w); um1[7] = bf_hi(b2.w); }
                    else { const float* cc = cache_conv + ((size_t)(layer * DECB + b) * 2) * 512 + ch;
#pragma unroll
                        for (int e = 0; e < 8; ++e) { um2[e] = cc[e]; um1[e] = cc[512 + e]; } }
                }
#pragma unroll
                for (int rr = 0; rr < 8; ++rr) { const size_t row = (size_t)row0 + rr;
                    const u32x4 uu = *(const u32x4*)(Ub + row * 512 + ch), wb = *(const u32x4*)(WBb + row * 512 + ch);
                    float uc[8] = {bf_lo(uu.x), bf_hi(uu.x), bf_lo(uu.y), bf_hi(uu.y), bf_lo(uu.z), bf_hi(uu.z), bf_lo(uu.w), bf_hi(uu.w)};
                    const float wv[8] = {bf_lo(wb.x), bf_hi(wb.x), bf_lo(wb.y), bf_hi(wb.y), bf_lo(wb.z), bf_hi(wb.z), bf_lo(wb.w), bf_hi(wb.w)};
                    float ov[8];
#pragma unroll
                    for (int e = 0; e < 8; ++e) { ov[e] = wv[e] * (w0[e] * um2[e] + w1[e] * um1[e] + w2[e] * uc[e] + bb_[e]); um2[e] = um1[e]; um1[e] = uc[e]; }
                    u32x4 w; w.x = cvt_pk_bf16(ov[0], ov[1]); w.y = cvt_pk_bf16(ov[2], ov[3]); w.z = cvt_pk_bf16(ov[4], ov[5]); w.w = cvt_pk_bf16(ov[6], ov[7]);
                    *(u32x4*)(ABX + row * 1536 + 512 + ch) = w; }
            }
#endif
        }
        SEAM(pbase + 1);
#ifndef NO_C
        for (int rep_ = 0; rep_ < ((PROBE_DUP & 4) ? 2 : 1); ++rep_)
        if (IN(pbase + 2)) {
            pg8::Gemm g{(const char*)ABX, (const char*)(WP + (size_t)layer * 1024 * 1536), 1536, 1536, 512, 1024, 1024};
            pg8::Sched S; S.init(MP, 1024, G, bx, 3, 0);
            EpiBranch E{MG, ZB};
            pg8::gemm_phase<EpiBranch, pg8::Sched, true, true>(ldsl, g, S, E);
        }
#endif
        SEAM(pbase + 2);
#ifndef NO_D
        for (int rep_ = ((PROBE_DUP & 8) ? 0 : 1); rep_ < 2; ++rep_)
        if (IN(pbase + 3)) {
            pg8::Gemm g{(const char*)ZB, (const char*)(WO + (size_t)layer * 1024 * 1024), 1024, 1024, 1024, 0, 0};
            pg8::Sched S; S.init(MP, 1024, G, bx, 1, 0);
            EpiOut E{layer == 0 ? x_prompt : out + O_YP, layer == 0 ? x_sample : out + O_YS, rep_ ? out : ZF, rep_ ? XB : ABX, SS + (size_t)(rep_ ? layer + 1 : 6) * MT};
            pg8::gemm_phase<EpiOut, pg8::Sched, true, true>(ldsl, g, S, E);
        }
#endif
        SEAM(pbase + 3);
    }
    if (IN(N_PHASES - 1)) {
        const float* ssf = SS + (size_t)DEPTH * MT;
        int m0, m1, mstep;
        if (bx >= G - NS) {
            const int si = bx - (G - NS);
            { pg8::Gemm gc{(const char*)ABX, (const char*)(WP + (size_t)(DEPTH - 1) * 1024 * 1536), 1536, 1536, 512, 1024, 1024};
              pg8::SchedS Sc{64, si, NS, 4, 3}; EpiBranch Ec{MG, ZB};
              pg8::gemm_phase<EpiBranch, pg8::SchedS, true, true>(ldsl, gc, Sc, Ec); }
            s_barrier_n(ctl + CW_SBAR, (unsigned)(NS * (2 * DEPTH - 1)), ctl + CW_BAR + XB_TMO);
            { pg8::Gemm gd{(const char*)ZB, (const char*)(WO + (size_t)(DEPTH - 1) * 1024 * 1024), 1024, 1024, 1024, 0, 0};
              pg8::SchedS Sd{64, si, NS, 4, 1};
              EpiOut Ed{out + O_YP, out + O_YS, out, XB, SS + (size_t)DEPTH * MT};
              pg8::gemm_phase<EpiOut, pg8::SchedS, true, true>(ldsl, gd, Sd, Ed); }
            s_barrier_n(ctl + CW_SBAR, (unsigned)(NS * (2 * DEPTH)), ctl + CW_BAR + XB_TMO);
            m0 = MP + si * NWAVES + wave; m1 = MT; mstep = NS * NWAVES;
        } else { m0 = bx * NWAVES + wave; m1 = MP; mstep = (G - NS) * NWAVES; }
        f32x4 gv[4];
#pragma unroll
        for (int j = 0; j < 4; ++j) gv[j] = ((const f32x4*)final_g)[lane + 64 * j];
        for (int m = m0; m < m1; m += mstep) { const float r = rsqrtf(ssf[m] * (1.0f / 1024.0f) + EPS); f32x4* xr = (f32x4*)(out + (size_t)m * 1024) + lane;
#pragma unroll
            for (int j = 0; j < 4; ++j) xr[64 * j] = xr[64 * j] * r * gv[j]; }
    }
#undef IN
#undef SEAM
}

extern "C" void kernel_launch(void* const* d_in, const int* in_sizes, int n_in, void* d_out, int out_size, void* d_ws, size_t ws_size, hipStream_t stream) {
    static int grid = 0;
    if (grid == 0) {
        if (n_in != 21 || in_sizes[0] != MP * DM || out_size != (int)O_TOTAL || ws_size < WS_END) {
            fprintf(stderr, "kernel_launch: shape mismatch: n_in %d in0 %d out %d ws %zu (need %zu); nothing launched\n", n_in, n_in > 0 ? in_sizes[0] : -1, out_size, ws_size, (size_t)WS_END); grid = -1; return; }
        int dev = 0, cus = 0, per_cu = 0;
        if (hipGetDevice(&dev) != hipSuccess || hipDeviceGetAttribute(&cus, hipDeviceAttributeMultiprocessorCount, dev) != hipSuccess) { fprintf(stderr, "kernel_launch: device query failed\n"); grid = -1; return; }
        if (hipFuncSetAttribute((const void*)fwd_kernel, hipFuncAttributeMaxDynamicSharedMemorySize, LDS_BYTES) != hipSuccess) { fprintf(stderr, "kernel_launch: hipFuncSetAttribute failed\n"); grid = -1; return; }
        if (hipOccupancyMaxActiveBlocksPerMultiprocessor(&per_cu, (const void*)fwd_kernel, NWAVES * 64, LDS_BYTES) != hipSuccess || per_cu < 1) {
            fprintf(stderr, "kernel_launch: occupancy query reports %d workgroups per CU; nothing launched\n", per_cu); (void)hipGetLastError(); grid = -1; return; }
        (void)hipGetLastError();
        grid = cus;
    }
    if (grid < 0) return;
    if (hipMemsetAsync((char*)d_ws + WS_CTL, 0, CTL_ZERO_BYTES, stream) != hipSuccess) { fprintf(stderr, "kernel_launch: memset failed\n"); return; }
    Args a{};
    for (int i = 0; i < 21; ++i) a.in[i] = d_in[i];
    a.out = (float*)d_out; a.ws = (unsigned char*)d_ws;
#if MK_N_LAUNCHES == 1
    a.ph_lo = 0; a.ph_hi = N_PHASES;
    hipLaunchKernelGGL(fwd_kernel, dim3(grid), dim3(NWAVES * 64), LDS_BYTES, stream, a);
#else
    for (int p = 0; p < N_PHASES; ++p) { a.ph_lo = p; a.ph_hi = p + 1; hipLaunchKernelGGL(fwd_kernel, dim3(grid), dim3(NWAVES * 64), LDS_BYTES, stream, a); }
#endif
    const hipError_t le = hipPeekAtLastError();
    if (le != hipSuccess) fprintf(stderr, "kernel_launch: launch failed: %s\n", hipGetErrorName(le));
}
```

```cpp
#include <hip/hip_runtime.h>
#include <hip/hip_bf16.h>
#include <cstdio>
#include <cstdint>

#ifndef MK_N_LAUNCHES
#define MK_N_LAUNCHES 1
#endif
#ifndef PROBE_DUP
#define PROBE_DUP 0
#endif

constexpr int DM = 1024, NBATCH = 2, SEQ = 8192, DEPTH = 4, DECB = 8, DECS = 32;
constexpr int MP = NBATCH * SEQ, MS = DECB * DECS, MT = MP + MS;
constexpr int NIN = 7424;
constexpr int NMEM = 256, MEMROWS = NBATCH * NMEM;
constexpr float EPS = 1e-6f;
constexpr float LOG2E = 1.4426950408889634f;
constexpr float QSCALE = 0.125f * LOG2E;

constexpr size_t O_YP = 0, O_YS = 16777216, O_KP = 17039360, O_VP = 17170432, O_CP = 17301504, O_MKP = 17309696, O_MVP = 18358272,
                 O_KS = 19406848, O_VS = 19537920, O_CS = 19668992, O_TOTAL = 19701760;

constexpr size_t MiB = 1u << 20;
constexpr size_t WS_CTL = 0, CTL_ZERO_BYTES = 1 * MiB;
constexpr size_t WS_SS = 256 * 1024;
constexpr size_t WS_WIN = 2 * MiB;
constexpr size_t WS_WP = 60 * MiB;
constexpr size_t WS_WO = 72 * MiB;
constexpr size_t WS_WM = 80 * MiB;
constexpr size_t WS_XB = 88 * MiB;
constexpr size_t WS_MEMB = 121 * MiB;
constexpr size_t WS_RMEM = 122 * MiB;
constexpr size_t WS_CKB = 123 * MiB, WS_CVB = 124 * MiB;
constexpr size_t WS_CMK = 125 * MiB, WS_CMV = 133 * MiB;
constexpr size_t WS_MK = 141 * MiB, WS_MV = 143 * MiB;
constexpr size_t WS_MG = 145 * MiB;
constexpr size_t WS_ABX = 243 * MiB;
constexpr size_t WS_Q = 292 * MiB, WS_GA = 309 * MiB, WS_U = 326 * MiB, WS_WB = 343 * MiB, WS_XQ = 360 * MiB, WS_GX = 377 * MiB;
constexpr size_t WS_K = 394 * MiB, WS_V = 399 * MiB;
constexpr size_t WS_ZF = 292 * MiB;
constexpr size_t WS_ZB = 404 * MiB;
constexpr size_t WS_END = 437 * MiB;
static_assert(WS_SS + 5 * (size_t)MT * 4 <= CTL_ZERO_BYTES, "SS inside memset region");
static_assert(WS_WIN + (size_t)4 * NIN * 1024 * 2 <= WS_WP && WS_XB + (size_t)MT * 1024 * 2 <= WS_MEMB && WS_MG + (size_t)MT * 3072 * 2 <= WS_ABX &&
              WS_ABX + (size_t)MT * 1536 * 2 <= WS_Q && WS_Q + (size_t)MT * 512 * 2 <= WS_GA && WS_K + (size_t)MT * 128 * 2 <= WS_V && WS_V + (size_t)MT * 128 * 2 <= WS_END &&
              WS_ZF + (size_t)MT * 1024 * 4 <= WS_K && WS_ZB + (size_t)MT * 1024 * 2 <= WS_END, "ws map");

typedef unsigned short bf16_t;
typedef short bf16x8 __attribute__((ext_vector_type(8)));
typedef short s16x4 __attribute__((ext_vector_type(4)));
typedef float f32x4 __attribute__((ext_vector_type(4)));
typedef float f32x16 __attribute__((ext_vector_type(16)));
typedef unsigned u32x4 __attribute__((ext_vector_type(4)));
typedef unsigned u32x2 __attribute__((ext_vector_type(2)));
#define LAS __attribute__((address_space(3)))
#define GAS __attribute__((address_space(1)))

__device__ __forceinline__ unsigned cvt_pk_bf16(float lo, float hi) { unsigned r; asm volatile("v_cvt_pk_bf16_f32 %0, %1, %2" : "=v"(r) : "v"(lo), "v"(hi)); return r; }
__device__ __forceinline__ float bf_lo(unsigned w) { return __uint_as_float(w << 16); }
__device__ __forceinline__ float bf_hi(unsigned w) { return __uint_as_float(w & 0xffff0000u); }
__device__ __forceinline__ float sigmoidf_(float x) { return __builtin_amdgcn_rcpf(1.f + __builtin_amdgcn_exp2f(-x * LOG2E)); }
__device__ __forceinline__ float siluf_(float x) { return x * sigmoidf_(x); }
__device__ __forceinline__ void st8(bf16_t* p, f32x4 v0, f32x4 v1) { u32x4 w; w.x = cvt_pk_bf16(v0[0], v0[1]); w.y = cvt_pk_bf16(v0[2], v0[3]); w.z = cvt_pk_bf16(v1[0], v1[1]); w.w = cvt_pk_bf16(v1[2], v1[3]); *(u32x4*)p = w; }

__device__ __forceinline__ void st8_wt(bf16_t* p, f32x4 v0, f32x4 v1) { u32x4 w; w.x = cvt_pk_bf16(v0[0], v0[1]); w.y = cvt_pk_bf16(v0[2], v0[3]); w.z = cvt_pk_bf16(v1[0], v1[1]); w.w = cvt_pk_bf16(v1[2], v1[3]);
    asm volatile("global_store_dwordx4 %0, %1, off sc1\n\ts_nop 1" :: "v"(p), "v"(w) : "memory"); }

namespace pg8 {
constexpr int BM = 256, BK = 64, HALF = 128, HTB = HALF * BK * 2, STAGE_BYTES = 8 * HTB, NXCD = 8, WGM = 8;
__host__ __device__ __forceinline__ int lds_byte(int r, int c) { const int st = (r >> 4) * 2 + (c >> 5), rr = r & 15, cc = c & 31, ob = rr * 64 + cc * 2; return st * 1024 + (ob ^ (((ob >> 9) & 1) << 5)); }
__host__ __device__ __forceinline__ void stage_rc(int b, int& R, int& C) { const int st = b / 1024, sb = b % 1024, swz = sb ^ (((sb >> 9) & 1) << 5); R = (st >> 1) * 16 + swz / 64; C = (st & 1) * 32 + (swz % 64) / 2; }
__host__ __device__ __forceinline__ int perm32(int rho) { const int n = rho >> 4, i = rho & 15; return 8 * (i >> 2) + 4 * n + (i & 3); }

struct Unit { int pm, pn, z; };
struct Gemm { const char* A; const char* B; int lda, ldb, K; long azstep, bzstep; };

struct Sched {
    int nM, nN, nwg, G, c, nz, nextra;
    __device__ void init(int M, int N, int G_, int c_, int nz_, int nextra_) { nM = M / BM; nN = N / BM; nwg = nM * nN; G = G_; c = c_; nz = nz_; nextra = nextra_; }
    __device__ bool next(int i, Unit& u) const {
        const int round = i / nz; u.z = i - round * nz;
        const long L = (long)round * G + c; if (L >= nwg + nextra) return false;
        if (L >= nwg) { const int j = (int)(L - nwg); u.pm = j & 1; u.pn = j >> 1; u.z = 1; return true; }
        int wgid = (int)L; { const int q = nwg / NXCD, r = nwg % NXCD, xcd = wgid % NXCD, off = wgid / NXCD; wgid = (xcd < r ? xcd * (q + 1) : r * (q + 1) + (xcd - r) * q) + off; }
        const int nig = WGM * nN, gid = wgid / nig, fm = gid * WGM, gsz = (nM - fm) < WGM ? (nM - fm) : WGM;
        u.pm = fm + ((wgid % nig) % gsz); u.pn = (wgid % nig) / gsz; return true;
    }
};

struct SchedS {
    int pm, pn0, pnstep, npn, nz;
    __device__ bool next(int i, Unit& u) const { const int round = i / nz; const int pn = pn0 + round * pnstep; if (pn >= npn) return false; u.pm = pm; u.pn = pn; u.z = i - round * nz; return true; }
};

template <class Epi, class SchedT, bool ALIGN_EPI, bool SP2>
__device__ __forceinline__ void gemm_phase(LAS unsigned char* lds, const Gemm g, const SchedT& S, const Epi& E) {
    int tid = threadIdx.x; asm volatile("" : "+v"(tid));
    const int wid = __builtin_amdgcn_readfirstlane(tid >> 6), lane = tid & 63, wr = wid >> 2, wc = wid & 3, fr = lane & 15, fq = lane >> 4;
    const int nt = g.K / BK;
    unsigned voffA[2], voffB[2];
#pragma unroll
    for (int i = 0; i < 2; ++i) { int R, C; stage_rc(tid * 16 + i * 8192, R, C); const int Rb = Epi::PERM ? ((R & ~31) + perm32(R & 31)) : R;
        voffA[i] = (unsigned)(R * g.lda + C) * 2u; voffB[i] = (unsigned)(Rb * g.ldb + C) * 2u; }
    const size_t kstep = (size_t)(BK * 2);
    const size_t hstepA = (size_t)HALF * g.lda * 2, hstepB = (size_t)HALF * g.ldb * 2;
    const size_t tstepA = 2 * hstepA, tstepB = 2 * hstepB;
    const unsigned ldsw = (unsigned)wid * 1024u;
    const int aoff = lds_byte(wr * 64 + fr, fq * 8), boff = lds_byte(wc * 32 + fr, fq * 8);
#define PG8_SA(b, h) (((b) * 2 + (h)) * HTB)
#define PG8_SB(b, h) ((4 + (b) * 2 + (h)) * HTB)
#define PG8_STAGE(bufoff, gbase, voff) do { _Pragma("unroll") for (int _i = 0; _i < 2; ++_i) \
        __builtin_amdgcn_global_load_lds((const unsigned*)((const char*)(gbase) + (voff)[_i]), (LAS unsigned*)(lds + (bufoff) + ldsw + _i * 8192), 16, 0, 0); } while (0)
#define PG8_LDA(dst, b, h) do { _Pragma("unroll") for (int m = 0; m < 4; ++m) _Pragma("unroll") for (int k = 0; k < 2; ++k) dst[m][k] = *(const LAS bf16x8*)(lds + PG8_SA(b, h) + aoff + m * 2048 + k * 1024); } while (0)
#define PG8_LDB(dst, b, h) do { _Pragma("unroll") for (int n = 0; n < 2; ++n) _Pragma("unroll") for (int k = 0; k < 2; ++k) dst[n][k] = *(const LAS bf16x8*)(lds + PG8_SB(b, h) + boff + n * 2048 + k * 1024); } while (0)
#define PG8_MMA(ai, bj, At, Bt) do { __builtin_amdgcn_s_setprio(1); _Pragma("unroll") for (int m = 0; m < 4; ++m) _Pragma("unroll") for (int n = 0; n < 2; ++n) _Pragma("unroll") for (int k = 0; k < 2; ++k) \
        acc[ai][bj][m][n] = __builtin_amdgcn_mfma_f32_16x16x32_bf16(Bt[n][k], At[m][k], acc[ai][bj][m][n], 0, 0, 0); __builtin_amdgcn_s_setprio(0); } while (0)
#define PG8_WAIT_V(n) asm volatile("s_waitcnt vmcnt(" #n ")" ::: "memory")
#define PG8_WAIT_L(n) asm volatile("s_waitcnt lgkmcnt(" #n ")" ::: "memory")
#define PG8_BAR __builtin_amdgcn_s_barrier()
#define PG8_SCHED __builtin_amdgcn_sched_barrier(0)
    Unit cur, nxt; int ui = 0;
    if (!S.next(0, cur)) return;
    f32x4 acc[2][2][4][2];
#pragma unroll
    for (int a = 0; a < 2; ++a)
#pragma unroll
        for (int b = 0; b < 2; ++b)
#pragma unroll
            for (int m = 0; m < 4; ++m)
#pragma unroll
                for (int n = 0; n < 2; ++n) acc[a][b][m][n] = (f32x4){0.f, 0.f, 0.f, 0.f};
    bf16x8 At[4][2], B0[2][2], B1[2][2];
    const char* cA = g.A + (size_t)cur.pm * tstepA + (long)cur.z * g.azstep; const char* cB = g.B + (size_t)cur.pn * tstepB + (long)cur.z * g.bzstep;
    if constexpr (SP2) {
        PG8_STAGE(PG8_SB(0, 0), cB, voffB); PG8_STAGE(PG8_SB(0, 1), cB + hstepB, voffB); PG8_STAGE(PG8_SA(0, 0), cA, voffA); PG8_STAGE(PG8_SA(0, 1), cA + hstepA, voffA);
        if (wr == 1) PG8_BAR;
        PG8_WAIT_V(2); PG8_BAR;
        PG8_STAGE(PG8_SB(1, 0), cB + kstep, voffB); PG8_STAGE(PG8_SA(1, 0), cA + kstep, voffA); PG8_STAGE(PG8_SB(1, 1), cB + hstepB + kstep, voffB);
        PG8_WAIT_V(6); PG8_BAR;
    } else {
        PG8_STAGE(PG8_SB(0, 0), cB, voffB); PG8_STAGE(PG8_SA(0, 0), cA, voffA); PG8_STAGE(PG8_SB(0, 1), cB + hstepB, voffB); PG8_STAGE(PG8_SA(0, 1), cA + hstepA, voffA);
        if (wr == 1) PG8_BAR;
        PG8_WAIT_V(4); PG8_BAR;
        PG8_STAGE(PG8_SB(1, 0), cB + kstep, voffB); PG8_STAGE(PG8_SA(1, 0), cA + kstep, voffA); PG8_STAGE(PG8_SB(1, 1), cB + hstepB + kstep, voffB);
        PG8_WAIT_V(6); PG8_BAR;
    }
    for (;;) {
        const bool has_next = S.next(ui + 1, nxt);
        const char* nA = has_next ? g.A + (size_t)nxt.pm * tstepA + (long)nxt.z * g.azstep : cA; const char* nB = has_next ? g.B + (size_t)nxt.pn * tstepB + (long)nxt.z * g.bzstep : cB;
        for (int t = 0; t < nt; t += 2) {
            const bool last = (t == nt - 2);
            const char* a1 = cA + (size_t)(t + 1) * kstep;
            const char* a2 = last ? nA : cA + (size_t)(t + 2) * kstep; const char* b2 = last ? nB : cB + (size_t)(t + 2) * kstep;
            const char* a3 = a2 + kstep; const char* b3 = b2 + kstep;
            if constexpr (SP2) {
            PG8_LDB(B0, 0, 0); PG8_LDB(B1, 0, 1); PG8_SCHED; PG8_LDA(At, 0, 0); PG8_STAGE(PG8_SA(1, 1), a1 + hstepA, voffA);
            PG8_WAIT_V(8); PG8_WAIT_L(0); PG8_BAR; PG8_MMA(0, 0, At, B0); PG8_MMA(0, 1, At, B1); PG8_BAR; PG8_SCHED;
            PG8_LDA(At, 0, 1); PG8_STAGE(PG8_SB(0, 0), b2, voffB); PG8_STAGE(PG8_SB(0, 1), b2 + hstepB, voffB); PG8_STAGE(PG8_SA(0, 0), a2, voffA);
            PG8_WAIT_V(8); PG8_WAIT_L(0); PG8_BAR; PG8_MMA(1, 0, At, B0); PG8_MMA(1, 1, At, B1); PG8_BAR; PG8_SCHED;
            PG8_LDB(B0, 1, 0); PG8_LDB(B1, 1, 1); PG8_SCHED; PG8_LDA(At, 1, 0); PG8_STAGE(PG8_SA(0, 1), a2 + hstepA, voffA);
            PG8_WAIT_V(8); PG8_WAIT_L(0); PG8_BAR; PG8_MMA(0, 0, At, B0); PG8_MMA(0, 1, At, B1); PG8_BAR; PG8_SCHED;
            PG8_LDA(At, 1, 1); PG8_STAGE(PG8_SB(1, 0), b3, voffB); PG8_STAGE(PG8_SB(1, 1), b3 + hstepB, voffB); PG8_STAGE(PG8_SA(1, 0), a3, voffA);
            PG8_WAIT_V(8); PG8_WAIT_L(0); PG8_BAR; PG8_MMA(1, 0, At, B0); PG8_MMA(1, 1, At, B1); PG8_BAR; PG8_SCHED;
            } else {
            PG8_LDB(B0, 0, 0); PG8_SCHED; PG8_LDA(At, 0, 0); PG8_STAGE(PG8_SA(1, 1), a1 + hstepA, voffA);
            PG8_WAIT_L(8); PG8_BAR; PG8_WAIT_L(0); PG8_MMA(0, 0, At, B0); PG8_BAR; PG8_SCHED;
            PG8_LDB(B1, 0, 1); PG8_STAGE(PG8_SB(0, 0), b2, voffB);
            PG8_BAR; PG8_WAIT_L(0); PG8_MMA(0, 1, At, B1); PG8_BAR;
            PG8_LDA(At, 0, 1); PG8_STAGE(PG8_SA(0, 0), a2, voffA);
            PG8_BAR; PG8_WAIT_L(0); PG8_MMA(1, 0, At, B0); PG8_BAR; PG8_SCHED;
            PG8_STAGE(PG8_SB(0, 1), b2 + hstepB, voffB);
            PG8_WAIT_V(6); PG8_BAR; PG8_MMA(1, 1, At, B1); PG8_BAR;
            PG8_LDB(B0, 1, 0); PG8_SCHED; PG8_LDA(At, 1, 0); PG8_STAGE(PG8_SA(0, 1), a2 + hstepA, voffA);
            PG8_WAIT_L(8); PG8_BAR; PG8_WAIT_L(0); PG8_MMA(0, 0, At, B0); PG8_BAR; PG8_SCHED;
            PG8_LDB(B1, 1, 1); PG8_STAGE(PG8_SB(1, 0), b3, voffB);
            PG8_BAR; PG8_WAIT_L(0); PG8_MMA(0, 1, At, B1); PG8_BAR;
            PG8_LDA(At, 1, 1); PG8_STAGE(PG8_SA(1, 0), a3, voffA);
            PG8_BAR; PG8_WAIT_L(0); PG8_MMA(1, 0, At, B0); PG8_BAR; PG8_SCHED;
            PG8_STAGE(PG8_SB(1, 1), b3 + hstepB, voffB);
            PG8_WAIT_V(6); PG8_BAR; PG8_MMA(1, 1, At, B1); PG8_BAR;
            }
        }
        if constexpr (ALIGN_EPI) { if (wr == 0) PG8_BAR; }
        const bool keep = E(acc, cur, wr, wc, fr, fq);
        if (!has_next) break;
        if (!keep) {
#pragma unroll
        for (int a = 0; a < 2; ++a)
#pragma unroll
            for (int b = 0; b < 2; ++b)
#pragma unroll
                for (int m = 0; m < 4; ++m)
#pragma unroll
                    for (int n = 0; n < 2; ++n) acc[a][b][m][n] = (f32x4){0.f, 0.f, 0.f, 0.f};
        }
        cur = nxt; cA = nA; cB = nB; ++ui;
        if constexpr (ALIGN_EPI) { if (wr == 1) PG8_BAR; }
    }
    PG8_WAIT_V(0);
    if constexpr (!ALIGN_EPI) { if (wr == 0) PG8_BAR; }
    PG8_BAR;
#undef PG8_SA
#undef PG8_SB
#undef PG8_STAGE
#undef PG8_LDA
#undef PG8_LDB
#undef PG8_MMA
#undef PG8_WAIT_V
#undef PG8_WAIT_L
#undef PG8_BAR
#undef PG8_SCHED
}
}

struct EpiIn {
    static constexpr bool PERM = true;
    int layer; const float* ss; const float* rmem;
    bf16_t *Q, *Kb, *Vb, *GA, *U, *WB, *XQ, *GX, *MG, *MK, *MV; float* out;
    __device__ __forceinline__ bool operator()(f32x4 (&acc)[2][2][4][2], const pg8::Unit& u, int wr, int wc, int fr, int fq) const {
        int rowt = wr * 64 + fr, cl = wc * 32 + 8 * fq; asm volatile("" : "+v"(rowt), "+v"(cl));
        if (u.z == 1) {
            const int l = u.pn >> 2, q = u.pn & 3; bf16_t* dst = (q < 2 ? MK : MV) + (size_t)l * 512 * 512 + (q & 1) * 256 + cl; float* fo = out + (q < 2 ? O_MKP : O_MVP) + (size_t)l * 512 * 512 + (q & 1) * 256 + cl;
#pragma unroll
            for (int ai = 0; ai < 2; ++ai)
#pragma unroll
                for (int m = 0; m < 4; ++m) { const int row = u.pm * 256 + ai * 128 + rowt + m * 16; const float rs = rmem[row];
#pragma unroll
                    for (int bj = 0; bj < 2; ++bj) { const f32x4 v0 = acc[ai][bj][m][0] * rs, v1 = acc[ai][bj][m][1] * rs;
                        st8(dst + (size_t)row * 512 + bj * 128, v0, v1); *(f32x4*)(fo + (size_t)row * 512 + bj * 128) = v0; *(f32x4*)(fo + (size_t)row * 512 + bj * 128 + 4) = v1; }
                    asm volatile("" ::: "memory"); }
            return false;
        }
        const int pn = u.pn;
        bf16_t* o0; bf16_t* o1; int ld = 512, mode = 0; float sc = 1.f;
        if (pn < 2) { o0 = Q + pn * 256 + cl; o1 = o0 + 128; sc = QSCALE; }
        else if (pn == 2) { o0 = Kb + cl; o1 = Vb + cl; ld = 128; }
        else if (pn < 5) { o0 = GA + (pn - 3) * 256 + cl; o1 = o0 + 128; mode = 1; }
        else if (pn < 9) { o0 = U + (pn - 5) * 128 + cl; o1 = o0; mode = 3; }
        else if (pn < 13) { o0 = WB + (pn - 9) * 128 + cl; o1 = o0; mode = 4; }
        else if (pn < 15) { o0 = XQ + (pn - 13) * 256 + cl; o1 = o0 + 128; }
        else if (pn < 17) { o0 = GX + (pn - 15) * 256 + cl; o1 = o0 + 128; mode = 1; }
        else { o0 = MG + (pn - 17) * 256 + cl; o1 = o0 + 128; ld = 3072; mode = 2; }
        const float* ssr = ss + (size_t)u.pm * 256 + rowt;
#pragma unroll
        for (int ai = 0; ai < 2; ++ai)
#pragma unroll
            for (int m = 0; m < 4; ++m) {
                const int rt = ai * 128 + rowt + m * 16; const size_t roff = ((size_t)u.pm * 256 + rt) * ld; const float rs = rsqrtf(ssr[ai * 128 + m * 16] * (1.0f / 1024.0f) + EPS) * sc;
                f32x4 a00 = acc[ai][0][m][0] * rs, a01 = acc[ai][0][m][1] * rs, a10 = acc[ai][1][m][0] * rs, a11 = acc[ai][1][m][1] * rs;
                if (mode >= 3) {
                    if (mode == 3) { a00 = a00 * a10; a01 = a01 * a11; }
                    else {
#pragma unroll
                        for (int e = 0; e < 4; ++e) { a00[e] = a00[e] * siluf_(a10[e]); a01[e] = a01[e] * siluf_(a11[e]); } }
                    st8(o0 + roff, a00, a01);
                } else {
                    if (mode == 1) {
#pragma unroll
                        for (int e = 0; e < 4; ++e) { a00[e] = siluf_(a00[e]); a01[e] = siluf_(a01[e]); a10[e] = siluf_(a10[e]); a11[e] = siluf_(a11[e]); } }
                    else if (mode == 2) {
#pragma unroll
                        for (int e = 0; e < 4; ++e) { a00[e] = sigmoidf_(a00[e]); a01[e] = sigmoidf_(a01[e]); a10[e] = sigmoidf_(a10[e]); a11[e] = sigmoidf_(a11[e]); } }
                    st8(o0 + roff, a00, a01); st8(o1 + roff, a10, a11);
                }
                asm volatile("" ::: "memory");
            }
        const bool lastp = (u.pm == 31 || u.pm == 63), samp = (u.pm == 64);
        if ((pn == 2 || (pn >= 5 && pn < 9)) && (lastp || samp)) {
            const int bp = u.pm == 63 ? 1 : 0;
#pragma unroll
            for (int ai = 0; ai < 2; ++ai)
#pragma unroll
                for (int m = 0; m < 4; ++m) {
                    const int rt = ai * 128 + rowt + m * 16; const float rs = rsqrtf(ssr[ai * 128 + m * 16] * (1.0f / 1024.0f) + EPS);
                    const f32x4 a00 = acc[ai][0][m][0] * rs, a01 = acc[ai][0][m][1] * rs, a10 = acc[ai][1][m][0] * rs, a11 = acc[ai][1][m][1] * rs;
                    if (pn == 2) {
                        if (samp) { const size_t o = ((size_t)layer * 256 + rt) * 128 + cl; *(f32x4*)(out + O_KS + o) = a00; *(f32x4*)(out + O_KS + o + 4) = a01; *(f32x4*)(out + O_VS + o) = a10; *(f32x4*)(out + O_VS + o + 4) = a11; }
                        else if (ai == 1) { const size_t o = ((size_t)(layer * 2 + bp) * 128 + (rt - 128)) * 128 + cl;
                            *(f32x4*)(out + O_KP + o) = a00; *(f32x4*)(out + O_KP + o + 4) = a01; *(f32x4*)(out + O_VP + o) = a10; *(f32x4*)(out + O_VP + o + 4) = a11; }
                    } else {
                        const int ch = (pn - 5) * 128 + cl; const f32x4 u0 = a00 * a10, u1 = a01 * a11;
                        if (samp) { const int t = rt & 31, b = rt >> 5; if (t >= 30) { float* p = out + O_CS + ((size_t)(layer * 8 + b) * 2 + (t - 30)) * 512 + ch; *(f32x4*)p = u0; *(f32x4*)(p + 4) = u1; } }
                        else if (rt >= 254) { float* p = out + O_CP + ((size_t)(layer * 2 + bp) * 2 + (rt - 254)) * 512 + ch; *(f32x4*)p = u0; *(f32x4*)(p + 4) = u1; }
                    }
                    asm volatile("" ::: "memory");
                }
        }
        return false;
    }
};

struct EpiBranch {
    static constexpr bool PERM = true;
    const bf16_t* MG; bf16_t* ZB;
    __device__ __forceinline__ bool operator()(f32x4 (&acc)[2][2][4][2], const pg8::Unit& u, int wr, int wc, int fr, int fq) const {
        int rowt = wr * 64 + fr, cl = wc * 32 + 8 * fq; asm volatile("" : "+v"(rowt), "+v"(cl));
        const bf16_t* gp = MG + ((size_t)u.pm * 256 + rowt) * 3072 + u.z * 1024 + u.pn * 256 + cl;
        if (u.z < 2) {
#pragma unroll
            for (int ai = 0; ai < 2; ++ai)
#pragma unroll
                for (int m = 0; m < 4; ++m) {
#pragma unroll
                    for (int bj = 0; bj < 2; ++bj) { const bf16_t* g = gp + (size_t)(ai * 128 + m * 16) * 3072 + bj * 128;
                        const u32x4 ga = *(const u32x4*)g, gb = *(const u32x4*)(g + 1024);
#define RAT(x, y) ((x) * __builtin_amdgcn_rcpf(__builtin_fmaxf((y), 1e-30f)))
                        f32x4& v0 = acc[ai][bj][m][0]; f32x4& v1 = acc[ai][bj][m][1];
                        v0[0] *= RAT(bf_lo(ga.x), bf_lo(gb.x)); v0[1] *= RAT(bf_hi(ga.x), bf_hi(gb.x)); v0[2] *= RAT(bf_lo(ga.y), bf_lo(gb.y)); v0[3] *= RAT(bf_hi(ga.y), bf_hi(gb.y));
                        v1[0] *= RAT(bf_lo(ga.z), bf_lo(gb.z)); v1[1] *= RAT(bf_hi(ga.z), bf_hi(gb.z)); v1[2] *= RAT(bf_lo(ga.w), bf_lo(gb.w)); v1[3] *= RAT(bf_hi(ga.w), bf_hi(gb.w));
#undef RAT
                    }
                    asm volatile("" ::: "memory"); }
            return true;
        }
        bf16_t* zp = ZB + ((size_t)u.pm * 256 + rowt) * 1024 + u.pn * 256 + cl;
#pragma unroll
        for (int ai = 0; ai < 2; ++ai)
#pragma unroll
            for (int m = 0; m < 4; ++m) {
#pragma unroll
                for (int bj = 0; bj < 2; ++bj) { const u32x4 gw = *(const u32x4*)(gp + (size_t)(ai * 128 + m * 16) * 3072 + bj * 128);
                    f32x4 v0 = acc[ai][bj][m][0], v1 = acc[ai][bj][m][1];
                    v0[0] *= bf_lo(gw.x); v0[1] *= bf_hi(gw.x); v0[2] *= bf_lo(gw.y); v0[3] *= bf_hi(gw.y);
                    v1[0] *= bf_lo(gw.z); v1[1] *= bf_hi(gw.z); v1[2] *= bf_lo(gw.w); v1[3] *= bf_hi(gw.w);
                    st8(zp + (size_t)(ai * 128 + m * 16) * 1024 + bj * 128, v0, v1); }
                asm volatile("" ::: "memory"); }
        return false;
    }
};

struct EpiOut {
    static constexpr bool PERM = true;
    const float* xold_p; const float* xold_s; float* xnew; const bf16_t* XB; bf16_t* XBo; float* ssn;
    __device__ __forceinline__ bool operator()(f32x4 (&acc)[2][2][4][2], const pg8::Unit& u, int wr, int wc, int fr, int fq) const {
        int rowt = wr * 64 + fr, cl = wc * 32 + 8 * fq; asm volatile("" : "+v"(rowt), "+v"(cl));
#pragma unroll
        for (int ai = 0; ai < 2; ++ai)
#pragma unroll
            for (int m = 0; m < 4; ++m) { const size_t row = (size_t)u.pm * 256 + ai * 128 + rowt + m * 16; float sq = 0.f;
#pragma unroll
                for (int bj = 0; bj < 2; ++bj) { const int col = u.pn * 256 + bj * 128 + cl; f32x4 x0, x1;
                    if (xold_p) { const float* src = (row < (size_t)MP) ? xold_p + row * 1024 : xold_s + (row - MP) * 1024; x0 = *(const f32x4*)(src + col); x1 = *(const f32x4*)(src + col + 4); }
                    else { const u32x4 w = *(const u32x4*)(XB + row * 1024 + col); x0 = (f32x4){bf_lo(w.x), bf_hi(w.x), bf_lo(w.y), bf_hi(w.y)}; x1 = (f32x4){bf_lo(w.z), bf_hi(w.z), bf_lo(w.w), bf_hi(w.w)}; }
                    x0 += acc[ai][bj][m][0]; x1 += acc[ai][bj][m][1];
                    if (xnew) { *(f32x4*)(xnew + row * 1024 + col) = x0; *(f32x4*)(xnew + row * 1024 + col + 4) = x1; }
                    st8(XBo + row * 1024 + col, x0, x1);
                    sq += (x0[0] * x0[0] + x0[1] * x0[1]) + (x0[2] * x0[2] + x0[3] * x0[3]) + (x1[0] * x1[0] + x1[1] * x1[1]) + (x1[2] * x1[2] + x1[3] * x1[3]); }
                sq += __shfl_xor(sq, 16); sq += __shfl_xor(sq, 32);
                if (fq == 0) atomicAdd(ssn + row, sq); }
        return false;
    }
};

namespace wattn {
constexpr int SLOT = 8192;
constexpr int L_K = 0, L_V = 3 * SLOT, L_WS = 6 * SLOT, L_OST = L_WS + 8 * 256, L_END = L_OST + 8 * 4096;
__device__ __forceinline__ int crow(int r, int hi) { return (r & 3) + 8 * (r >> 2) + 4 * hi; }
struct Ptrs { const bf16_t *Q, *KB, *VB, *CKB, *CVB, *GA; bf16_t* ABX; const float* sink; };

__device__ __forceinline__ void pv(f32x16* o, int vb, bf16x8 pa0, bf16x8 pa1, bf16x8 pa2, bf16x8 pa3) {
#pragma unroll
    for (int d0 = 0; d0 < 2; ++d0) { s16x4 lo[4], hi[4];
#pragma unroll
        for (int ks = 0; ks < 4; ++ks) {
            asm volatile("ds_read_b64_tr_b16 %0,%1 offset:%c2" : "=&v"(lo[ks]) : "v"(vb), "i"(d0 * 4096 + ks * 1024) : "memory");
            asm volatile("ds_read_b64_tr_b16 %0,%1 offset:%c2" : "=&v"(hi[ks]) : "v"(vb), "i"(d0 * 4096 + ks * 1024 + 512) : "memory"); }
        asm volatile("s_waitcnt lgkmcnt(0)" ::: "memory"); __builtin_amdgcn_sched_barrier(0);
#define WPK(k) (bf16x8){lo[k][0], lo[k][1], lo[k][2], lo[k][3], hi[k][0], hi[k][1], hi[k][2], hi[k][3]}
        o[d0] = __builtin_amdgcn_mfma_f32_32x32x16_bf16(pa0, WPK(0), o[d0], 0, 0, 0);
        o[d0] = __builtin_amdgcn_mfma_f32_32x32x16_bf16(pa1, WPK(1), o[d0], 0, 0, 0);
        o[d0] = __builtin_amdgcn_mfma_f32_32x32x16_bf16(pa2, WPK(2), o[d0], 0, 0, 0);
        o[d0] = __builtin_amdgcn_mfma_f32_32x32x16_bf16(pa3, WPK(3), o[d0], 0, 0, 0);
#undef WPK
    }
}

__device__ __forceinline__ void unit(char* shm, const Ptrs& P, int layer, bool sample, int b, int c, int g) {
    int tid = threadIdx.x; asm volatile("" : "+v"(tid));
    const int lane = tid & 63, r32 = lane & 31, hi = lane >> 5; const int wid = __builtin_amdgcn_readfirstlane(tid >> 6);
    const int qrow0 = sample ? MP + 32 * b : b * SEQ + 64 * c;
    const int t0 = sample ? 0 : (c >= 2 ? 0 : 2 - c);
#pragma unroll
    for (int t = 0; t < 3; ++t) {
        if (t >= t0) {
            const bf16_t *kb, *vb; int clampr;
            if (sample && t < 2) { const size_t off = ((size_t)(layer * 8 + b) * 128 + 64 * t) * 128; kb = P.CKB + off; vb = P.CVB + off; clampr = 63; }
            else { const size_t row = sample ? (size_t)qrow0 : (size_t)(qrow0 - 128 + 64 * t); kb = P.KB + row * 128; vb = P.VB + row * 128; clampr = sample ? 31 : 63; }
            const int key = lane < clampr ? lane : clampr;
            const u32x4 kv = *(const u32x4*)(kb + (size_t)key * 128 + g * 64 + wid * 8);
            int vkey = 16 * (wid & 3) + (lane >> 2); vkey = vkey < clampr ? vkey : clampr; const int vd = (wid >> 2) * 32 + (lane & 3) * 8;
            const u32x4 vv = *(const u32x4*)(vb + (size_t)vkey * 128 + g * 64 + vd);
            *(u32x4*)(shm + L_K + t * SLOT + tid * 16) = kv;
            *(u32x4*)(shm + L_V + t * SLOT + tid * 16) = vv;
        }
    }
    __syncthreads();
    const int nrb = sample ? 1 : 2;
    if (wid < 4 * nrb) {
        const int j = sample ? wid : (wid >> 1), rb = sample ? 0 : (wid & 1);
        const int head = 4 * g + j, qi = rb * 32 + r32;
        const bf16_t* qp = P.Q + (size_t)(qrow0 + qi) * 512 + head * 64 + hi * 8;
        bf16x8 qr[4];
#pragma unroll
        for (int d0 = 0; d0 < 4; ++d0) qr[d0] = *(const bf16x8*)(qp + d0 * 16);
        f32x16 p[3][2];
#pragma unroll
        for (int t = 0; t < 3; ++t) {
            if (t >= t0) {
#pragma unroll
                for (int blk = 0; blk < 2; ++blk) { f32x16 a = {};
#pragma unroll
                    for (int d0 = 0; d0 < 4; ++d0) { const bf16x8 kf = *(const bf16x8*)(shm + L_K + t * SLOT + (2 * d0 + hi) * 1024 + (blk * 32 + r32) * 16);
                        a = __builtin_amdgcn_mfma_f32_32x32x16_bf16(kf, qr[d0], a, 0, 0, 0); }
                    p[t][blk] = a; }
            } else {
#pragma unroll
                for (int blk = 0; blk < 2; ++blk)
#pragma unroll
                    for (int r = 0; r < 16; ++r) p[t][blk][r] = -1e30f;
            }
        }
        const float slope2 = __builtin_amdgcn_exp2f(-(float)(head + 1)) * LOG2E;
        const float sink2 = P.sink[layer * 8 + head] * LOG2E;
        float basef = (float)(qi + 128 - 4 * hi); asm volatile("" : "+v"(basef));
        float mx = sink2;
#pragma unroll
        for (int t = 0; t < 3; ++t)
#pragma unroll
            for (int blk = 0; blk < 2; ++blk)
#pragma unroll
                for (int r = 0; r < 16; ++r) {
                    const float kc = (float)(64 * t + 32 * blk + (r & 3) + 8 * (r >> 2));
                    float s = p[t][blk][r] - slope2 * __builtin_fabsf(basef - kc);
                    if (sample && t == 2 && blk == 1) s = -1e30f;
                    if (t < t0) s = -1e30f;
                    p[t][blk][r] = s; mx = __builtin_fmaxf(mx, s);
                }
        { auto rr = __builtin_amdgcn_permlane32_swap(__float_as_uint(mx), __float_as_uint(mx), false, false); mx = __builtin_fmaxf(__uint_as_float(rr[0]), __uint_as_float(rr[1])); }
        float sum = 0.f;
#pragma unroll
        for (int t = 0; t < 3; ++t)
#pragma unroll
            for (int blk = 0; blk < 2; ++blk)
#pragma unroll
                for (int r = 0; r < 16; ++r) { const float e = __builtin_amdgcn_exp2f(p[t][blk][r] - mx); p[t][blk][r] = e; sum += e; }
        { auto rr = __builtin_amdgcn_permlane32_swap(__float_as_uint(sum), __float_as_uint(sum), false, false); sum = __uint_as_float(rr[0]) + __uint_as_float(rr[1]); }
        const float l = sum + __builtin_amdgcn_exp2f(sink2 - mx);
        f32x16 o[2]; o[0] = f32x16{}; o[1] = f32x16{};
        const int vb0 = (int)(unsigned)(uintptr_t)(shm + L_V) + ((lane >> 4) & 1) * 32 + (lane & 3) * 8 + (4 * hi + ((lane & 15) >> 2)) * 64;
#pragma unroll
        for (int t = 0; t < 3; ++t) {
            if (t >= t0) {
                u32x4 w0, w1, w2, w3;
#define PKW(P_, B_) cvt_pk_bf16(P_[B_], P_[B_ + 1])
                w0 = (u32x4){PKW(p[t][0], 0), PKW(p[t][0], 2), PKW(p[t][0], 4), PKW(p[t][0], 6)};
                w1 = (u32x4){PKW(p[t][0], 8), PKW(p[t][0], 10), PKW(p[t][0], 12), PKW(p[t][0], 14)};
                w2 = (u32x4){PKW(p[t][1], 0), PKW(p[t][1], 2), PKW(p[t][1], 4), PKW(p[t][1], 6)};
                w3 = (u32x4){PKW(p[t][1], 8), PKW(p[t][1], 10), PKW(p[t][1], 12), PKW(p[t][1], 14)};
#undef PKW
                pv(o, vb0 + t * SLOT, __builtin_bit_cast(bf16x8, w0), __builtin_bit_cast(bf16x8, w1), __builtin_bit_cast(bf16x8, w2), __builtin_bit_cast(bf16x8, w3));
            }
        }
        float* wsf = (float*)(shm + L_WS) + wid * 64;
        if (hi == 0) wsf[r32] = l;
        asm volatile("s_waitcnt lgkmcnt(0)" ::: "memory");
        bf16_t* stg = (bf16_t*)(shm + L_OST) + wid * 2048;
#pragma unroll
        for (int r = 0; r < 16; ++r) { const int orow = crow(r, hi); const float rl = __builtin_amdgcn_rcpf(wsf[orow]);
#pragma unroll
            for (int d0 = 0; d0 < 2; ++d0) { const float v = o[d0][r] * rl; stg[orow * 64 + d0 * 32 + r32] = (bf16_t)(cvt_pk_bf16(v, v) & 0xffffu); } }
        asm volatile("s_waitcnt lgkmcnt(0)" ::: "memory");
#pragma unroll
        for (int i = 0; i < 4; ++i) { const int row = i * 8 + (lane >> 3), ch = lane & 7;
            const u32x4 ov = *(const u32x4*)(stg + row * 64 + ch * 8);
            const size_t grow = (size_t)(qrow0 + rb * 32 + row);
            const u32x4 gv = *(const u32x4*)(P.GA + grow * 512 + head * 64 + ch * 8);
            u32x4 w;
            w.x = cvt_pk_bf16(bf_lo(ov.x) * bf_lo(gv.x), bf_hi(ov.x) * bf_hi(gv.x)); w.y = cvt_pk_bf16(bf_lo(ov.y) * bf_lo(gv.y), bf_hi(ov.y) * bf_hi(gv.y));
            w.z = cvt_pk_bf16(bf_lo(ov.z) * bf_lo(gv.z), bf_hi(ov.z) * bf_hi(gv.z)); w.w = cvt_pk_bf16(bf_lo(ov.w) * bf_lo(gv.w), bf_hi(ov.w) * bf_hi(gv.w));
            *(u32x4*)(P.ABX + grow * 1536 + head * 64 + ch * 8) = w; }
    }
    __syncthreads();
}
}

namespace xattn {
constexpr int D = 128, NW = 8, QBLK = 32, KVBLK = 64;
constexpr float SCALE = 0.088388347648318440f;
constexpr float THR = 0.f;
constexpr int LDQ = 512, LDK = 512;
constexpr size_t SHM_V = KVBLK * D * 2, SHM_K = KVBLK * D * 2, SHM_ATTN = 2 * SHM_V + 2 * SHM_K + NW * 64 * 4;
constexpr int L_OST2 = (int)SHM_ATTN;
#define KSWZ(row, colB) ((row) * 256 + ((colB) ^ (((row) & 7) << 4)))
#define SBAR() __builtin_amdgcn_sched_barrier(0)
__device__ __forceinline__ int crow(int r, int hi) { return (r & 3) + 8 * (r >> 2) + 4 * hi; }
__device__ __forceinline__ void partialSM(f32x16& p0, f32x16& p1, float& m_reg, float& mn, float& alpha) {
    constexpr float C = SCALE * 1.4426950408889634f;
    float pmax = p0[0];
#pragma unroll
    for (int r = 1; r < 16; ++r) pmax = fmaxf(pmax, p0[r]);
#pragma unroll
    for (int r = 0; r < 16; ++r) pmax = fmaxf(pmax, p1[r]);
    { auto rr = __builtin_amdgcn_permlane32_swap(__float_as_uint(pmax), __float_as_uint(pmax), false, false); pmax = fmaxf(__uint_as_float(rr[0]), __uint_as_float(rr[1])); }
    if (__builtin_expect(__all(pmax - m_reg <= THR / SCALE), 1)) { mn = m_reg; alpha = 1.f; }
    else { mn = fmaxf(m_reg, pmax); alpha = __builtin_amdgcn_exp2f((m_reg - mn) * C); m_reg = mn; }
    const float mnC = -mn * C;
#pragma unroll
    for (int r = 0; r < 16; ++r) p0[r] = fmaf(p0[r], C, mnC);
#pragma unroll
    for (int r = 0; r < 16; ++r) p1[r] = fmaf(p1[r], C, mnC);
#pragma unroll
    for (int r = 0; r < 16; ++r) p0[r] = __builtin_amdgcn_exp2f(p0[r]);
}
__device__ __forceinline__ void finishSM(f32x16& p0, f32x16& p1, float alpha, float& l_reg, bf16x8& pa0, bf16x8& pa1, bf16x8& pa2, bf16x8& pa3) {
#pragma unroll
    for (int r = 0; r < 16; ++r) p1[r] = __builtin_amdgcn_exp2f(p1[r]);
    float ps = 0;
#pragma unroll
    for (int r = 0; r < 16; ++r) ps += p0[r];
#pragma unroll
    for (int r = 0; r < 16; ++r) ps += p1[r];
    { auto rr = __builtin_amdgcn_permlane32_swap(__float_as_uint(ps), __float_as_uint(ps), false, false); ps = __uint_as_float(rr[0]) + __uint_as_float(rr[1]); }
    l_reg = l_reg * alpha + ps;
#define PK4(P, BASE, OUT) do { unsigned a0 = cvt_pk_bf16(P[BASE + 0], P[BASE + 1]), a1 = cvt_pk_bf16(P[BASE + 2], P[BASE + 3]);   \
    unsigned b0 = cvt_pk_bf16(P[BASE + 4], P[BASE + 5]), b1 = cvt_pk_bf16(P[BASE + 6], P[BASE + 7]);                              \
    auto r0 = __builtin_amdgcn_permlane32_swap(a0, b0, false, false); auto r1 = __builtin_amdgcn_permlane32_swap(a1, b1, false, false); \
    u32x4 w = {r0[0], r1[0], r0[1], r1[1]}; OUT = __builtin_bit_cast(bf16x8, w); } while (0)
    PK4(p0, 0, pa0); PK4(p0, 8, pa1); PK4(p1, 0, pa2); PK4(p1, 8, pa3);
#undef PK4
}
__device__ __forceinline__ void qkt(f32x16& p0, f32x16& p1, const char* Ks, const bf16x8* qr, int r32, int hi) {
    p0 = f32x16{}; p1 = f32x16{};
#pragma unroll
    for (int d0 = 0; d0 < 8; ++d0) { const int cb = (d0 * 16 + hi * 8) * 2;
        const bf16x8 b0 = *reinterpret_cast<const bf16x8*>(Ks + KSWZ(r32, cb));
        const bf16x8 b1 = *reinterpret_cast<const bf16x8*>(Ks + KSWZ(32 + r32, cb));
        p0 = __builtin_amdgcn_mfma_f32_32x32x16_bf16(b0, qr[d0], p0, 0, 0, 0);
        p1 = __builtin_amdgcn_mfma_f32_32x32x16_bf16(b1, qr[d0], p1, 0, 0, 0); }
}
__device__ __forceinline__ int v_st(int k, int c) { const int kk = (k & ~0xC) | ((k & 4) << 1) | ((k & 8) >> 1); return ((kk >> 3) * 4 + (c >> 5)) * 512 + ((kk & 7) * 32 + (c & 31)) * 2; }
__device__ __forceinline__ int v_rd_base(int lane) { return ((lane & 3) << 3) | (((lane >> 2) & 3) << 6) | (((lane >> 4) & 1) << 5) | (((lane >> 5) & 1) << 8); }
constexpr int v_rd_off(int d0, int ks, int half) { return d0 * 512 + ks * 4096 + half * 2048; }
template <int OFF> __device__ __forceinline__ s16x4 tr_read(int vb) { s16x4 r; asm volatile("ds_read_b64_tr_b16 %0, %1 offset:%2" : "=&v"(r) : "v"(vb), "i"(OFF) : "memory"); return r; }
template <int D0> __device__ __forceinline__ void pv_one(f32x16& od, int vb, bf16x8 pa0, bf16x8 pa1, bf16x8 pa2, bf16x8 pa3) {
    const s16x4 l0 = tr_read<v_rd_off(D0, 0, 0)>(vb), h0 = tr_read<v_rd_off(D0, 0, 1)>(vb), l1 = tr_read<v_rd_off(D0, 1, 0)>(vb), h1 = tr_read<v_rd_off(D0, 1, 1)>(vb);
    const s16x4 l2 = tr_read<v_rd_off(D0, 2, 0)>(vb), h2 = tr_read<v_rd_off(D0, 2, 1)>(vb), l3 = tr_read<v_rd_off(D0, 3, 0)>(vb), h3 = tr_read<v_rd_off(D0, 3, 1)>(vb);
    asm volatile("s_waitcnt lgkmcnt(0)" ::: "memory"); SBAR();
#define XPK(L, H) (bf16x8){L[0], L[1], L[2], L[3], H[0], H[1], H[2], H[3]}
    od = __builtin_amdgcn_mfma_f32_32x32x16_bf16(pa0, XPK(l0, h0), od, 0, 0, 0);
    od = __builtin_amdgcn_mfma_f32_32x32x16_bf16(pa1, XPK(l1, h1), od, 0, 0, 0);
    od = __builtin_amdgcn_mfma_f32_32x32x16_bf16(pa2, XPK(l2, h2), od, 0, 0, 0);
    od = __builtin_amdgcn_mfma_f32_32x32x16_bf16(pa3, XPK(l3, h3), od, 0, 0, 0);
#undef XPK
}
__device__ __forceinline__ void pv_d0(f32x16* o, int vb, bf16x8 pa0, bf16x8 pa1, bf16x8 pa2, bf16x8 pa3) {
    pv_one<0>(o[0], vb, pa0, pa1, pa2, pa3); pv_one<1>(o[1], vb, pa0, pa1, pa2, pa3); pv_one<2>(o[2], vb, pa0, pa1, pa2, pa3); pv_one<3>(o[3], vb, pa0, pa1, pa2, pa3);
}
__device__ __forceinline__ void body(const bf16_t* __restrict__ Qb, const bf16_t* __restrict__ Kh, const bf16_t* __restrict__ Vh, const bf16_t* __restrict__ Gb, bf16_t* __restrict__ Ob, int nvw, char* lds) {
    constexpr int seq = 256;
    int tid = threadIdx.x; asm volatile("" : "+v"(tid));
    const int wid = __builtin_amdgcn_readfirstlane(tid >> 6), lane = tid & 63, r32 = lane & 31, hi = lane >> 5;
    const int widq = wid < nvw ? wid : 0;
    char* V_lds = lds; char* K_lds = lds + 2 * SHM_V;
    float* ws = (float*)(lds + 2 * SHM_V + 2 * SHM_K) + wid * 64; float* li_l = ws; float* al_l = ws + 32;
    float m_reg = -1e30f, l_reg = 0; f32x16 o[4] = {}; bf16x8 qr[8];
    const bf16_t* Qw = Qb + (long)(widq * QBLK + r32) * LDQ + hi * 8;
#pragma unroll
    for (int d0 = 0; d0 < 8; ++d0) qr[d0] = *reinterpret_cast<const bf16x8*>(Qw + d0 * 16);
    const int sr = tid >> 4, sc = (tid & 15) * 8, vst0 = v_st(sr, sc), vst1 = v_st(32 + sr, sc);
    const int vb0 = (int)(unsigned)(uintptr_t)V_lds + v_rd_base(lane);
    struct { bf16x8 vs0, vs1, ks0, ks1; } sr_[2];
#define SLOAD(i, k0) do { sr_[i].vs0 = *reinterpret_cast<const bf16x8*>(&Vh[(long)((k0) + sr) * LDK + sc]); sr_[i].vs1 = *reinterpret_cast<const bf16x8*>(&Vh[(long)((k0) + 32 + sr) * LDK + sc]); \
    sr_[i].ks0 = *reinterpret_cast<const bf16x8*>(&Kh[(long)((k0) + sr) * LDK + sc]); sr_[i].ks1 = *reinterpret_cast<const bf16x8*>(&Kh[(long)((k0) + 32 + sr) * LDK + sc]); } while (0)
#define SWRITE(b, i) do { *(bf16x8*)(V_lds + (b) * SHM_V + vst0) = sr_[i].vs0;          \
    *(bf16x8*)(V_lds + (b) * SHM_V + vst1) = sr_[i].vs1; const int kc = sc * 2;               \
    *(bf16x8*)(K_lds + (b) * SHM_K + KSWZ(sr, kc)) = sr_[i].ks0;                       \
    *(bf16x8*)(K_lds + (b) * SHM_K + KSWZ(32 + sr, kc)) = sr_[i].ks1; } while (0)
#define SWAIT() asm volatile("s_waitcnt vmcnt(4)" ::: "memory")
#define RESC(a) do { if (__any((a) < 1.f)) { if (hi == 0) al_l[r32] = (a); asm volatile("s_waitcnt lgkmcnt(0)" ::: "memory"); \
    _Pragma("unroll") for (int d = 0; d < 4; ++d) _Pragma("unroll") for (int r = 0; r < 16; ++r) o[d][r] *= al_l[crow(r, hi)]; } } while (0)
    f32x16 pA0, pA1, pB0, pB1; float mnA, mnB, alA, alB; bf16x8 pa0, pa1, pa2, pa3; constexpr int NT = seq / KVBLK;
    constexpr int SE = 0, SO = 1;
    SLOAD(SE, 0); asm volatile("s_waitcnt vmcnt(0)" ::: "memory"); SWRITE(0, SE); __syncthreads();
    qkt(pA0, pA1, K_lds, qr, r32, hi); partialSM(pA0, pA1, m_reg, mnA, alA);
    SLOAD(SO, KVBLK); if (2 < NT) SLOAD(SE, 2 * KVBLK);
    SWAIT(); SWRITE(1, SO); __syncthreads();
#pragma unroll 1
    for (int j = 1; j + 1 < NT; j += 2) {
        SBAR(); qkt(pB0, pB1, K_lds + SHM_K, qr, r32, hi);
        finishSM(pA0, pA1, alA, l_reg, pa0, pa1, pa2, pa3); SBAR();
        SLOAD(SO, (j + 2) * KVBLK); SBAR();
        pv_d0(o, vb0, pa0, pa1, pa2, pa3); partialSM(pB0, pB1, m_reg, mnB, alB);
        __syncthreads(); SWAIT(); SWRITE(0, SE);
        RESC(alB); __syncthreads();
        SBAR(); qkt(pA0, pA1, K_lds, qr, r32, hi);
        finishSM(pB0, pB1, alB, l_reg, pa0, pa1, pa2, pa3); SBAR();
        if (j + 3 < NT) SLOAD(SE, (j + 3) * KVBLK); SBAR();
        pv_d0(o, vb0 + (int)SHM_V, pa0, pa1, pa2, pa3); partialSM(pA0, pA1, m_reg, mnA, alA);
        __syncthreads(); SWAIT(); SWRITE(1, SO);
        RESC(alA); __syncthreads();
    }
    SBAR(); qkt(pB0, pB1, K_lds + SHM_K, qr, r32, hi);
    finishSM(pA0, pA1, alA, l_reg, pa0, pa1, pa2, pa3); SBAR();
    pv_d0(o, vb0, pa0, pa1, pa2, pa3); partialSM(pB0, pB1, m_reg, mnB, alB);
    __syncthreads(); RESC(alB);
    finishSM(pB0, pB1, alB, l_reg, pa0, pa1, pa2, pa3); SBAR();
    pv_d0(o, vb0 + (int)SHM_V, pa0, pa1, pa2, pa3);
    if (hi == 0) li_l[r32] = l_reg; asm volatile("s_waitcnt lgkmcnt(0)" ::: "memory");
    bf16_t* stg = (bf16_t*)(wid < 4 ? K_lds + wid * 8192 : lds + L_OST2 + (wid - 4) * 8192);
#pragma unroll
    for (int r = 0; r < 16; ++r) { const int orow = crow(r, hi); const float rl = __builtin_amdgcn_rcpf(li_l[orow]);
#pragma unroll
        for (int d0 = 0; d0 < 4; ++d0) { const float v = o[d0][r] * rl; stg[orow * 128 + d0 * 32 + r32] = (bf16_t)(cvt_pk_bf16(v, v) & 0xffffu); } }
    asm volatile("s_waitcnt lgkmcnt(0)" ::: "memory");
    if (wid < nvw) {
#pragma unroll
        for (int i = 0; i < 8; ++i) { const int row = i * 4 + (lane >> 4), ch = lane & 15;
            const u32x4 ov = *(const u32x4*)(stg + row * 128 + ch * 8);
            const long grow = (long)(wid * QBLK + row);
            const u32x4 gv = *(const u32x4*)(Gb + grow * 512 + ch * 8);
            u32x4 w;
            w.x = cvt_pk_bf16(bf_lo(ov.x) * bf_lo(gv.x), bf_hi(ov.x) * bf_hi(gv.x)); w.y = cvt_pk_bf16(bf_lo(ov.y) * bf_lo(gv.y), bf_hi(ov.y) * bf_hi(gv.y));
            w.z = cvt_pk_bf16(bf_lo(ov.z) * bf_lo(gv.z), bf_hi(ov.z) * bf_hi(gv.z)); w.w = cvt_pk_bf16(bf_lo(ov.w) * bf_lo(gv.w), bf_hi(ov.w) * bf_hi(gv.w));
            *(u32x4*)(Ob + grow * 1536 + ch * 8) = w; }
    }
    __syncthreads();
#undef SLOAD
#undef SWRITE
#undef SWAIT
#undef RESC
}
#undef KSWZ
#undef SBAR
}

typedef GAS unsigned gu32;
#define RLX_AGENT __ATOMIC_RELAXED, __HIP_MEMORY_SCOPE_AGENT
#define XB_TMO      128
#define XB_XCNT(j)  (256  + 64 * (j))
#define XB_XSUB(j)  (1280 + 64 * (j))
#define XB_XGEN(j)  (2304 + 64 * (j))
#define XB_TOP      3328
#define XB_TOPGEN   3392
#define XCD_BAR_WORDS 3456
#define XB_SPIN_CAP (1u << 18)
__device__ __forceinline__ unsigned xb_ld(unsigned* p)              { return __hip_atomic_load(p, __ATOMIC_RELAXED, __HIP_MEMORY_SCOPE_AGENT); }
__device__ __forceinline__ unsigned xb_add(unsigned* p, unsigned v) { return __hip_atomic_fetch_add(p, v, __ATOMIC_RELAXED, __HIP_MEMORY_SCOPE_AGENT); }
__device__ __forceinline__ unsigned xb_xcc_id() { return (unsigned)__builtin_amdgcn_s_getreg((3 << 11) | 20) & 0xFu; }
#define XB_SPIN(cond, bar) do { unsigned _sp = 0; while (cond) { __builtin_amdgcn_s_sleep(1); \
    if ((++_sp & 255u) == 0u) { if (xb_ld(&(bar)[XB_TMO])) break; if (_sp > XB_SPIN_CAP) { atomicAdd(&(bar)[XB_TMO], 1u); break; } } } } while (0)
struct XcdBarrier { unsigned* bar; unsigned x; volatile LAS unsigned* st; };
__device__ __forceinline__ XcdBarrier xcd_barrier_post(unsigned* bar, volatile LAS unsigned* st) {
    XcdBarrier b; b.bar = bar; b.x = xb_xcc_id(); b.st = st;
    if (threadIdx.x == 0) (void)xb_add(&bar[XB_XCNT(b.x)], 1u);
    return b;
}
__device__ __forceinline__ void xcd_barrier_complete(unsigned* bar, unsigned x, unsigned& nloc, unsigned& nx) {
    const unsigned G = gridDim.x * gridDim.y * gridDim.z;
    unsigned sum, cnt, mine, sp = 0u;
    for (;;) {
        sum = 0u; cnt = 0u; mine = 0u;
#pragma unroll
        for (unsigned j = 0; j < 16; ++j) { const unsigned c = xb_ld(&bar[XB_XCNT(j)]); sum += c; cnt += (c > 0u) ? 1u : 0u; mine = (j == x) ? c : mine; }
        if (sum == G) break;
        __builtin_amdgcn_s_sleep(1);
        if ((++sp & 255u) == 0u) { if (xb_ld(&bar[XB_TMO])) break; if (sp > XB_SPIN_CAP) { atomicAdd(&bar[XB_TMO], 1u); break; } }
    }
    nloc = mine > 0u ? mine : 1u; nx = cnt > 0u ? cnt : 1u;
}
__device__ __forceinline__ void xcd_barrier(const XcdBarrier& b) {
    asm volatile("s_waitcnt vmcnt(0)" ::: "memory");
    __syncthreads();
    if (threadIdx.x == 0) {
        unsigned* bar = b.bar;
        __builtin_amdgcn_s_waitcnt(0);
        unsigned nloc = b.st[0], nx = b.st[1];
        if (nloc == 0u) { xcd_barrier_complete(bar, b.x, nloc, nx); b.st[0] = nloc; b.st[1] = nx; }
        const unsigned old = xb_add(&bar[XB_XSUB(b.x)], 1u);
        const unsigned gen = old / nloc;
        if (old + 1u == (gen + 1u) * nloc) {
            __builtin_amdgcn_fence(__ATOMIC_RELEASE, "agent");
            asm volatile("s_waitcnt vmcnt(0)" ::: "memory");
            const unsigned og = xb_add(&bar[XB_TOP], 1u);
            const unsigned tg = og / nx;
            if (og + 1u == (tg + 1u) * nx) xb_add(&bar[XB_TOPGEN], 1u);
            else XB_SPIN(xb_ld(&bar[XB_TOPGEN]) == tg, bar);
            __builtin_amdgcn_fence(__ATOMIC_ACQUIRE, "agent");
            xb_add(&bar[XB_XGEN(b.x)], 1u);
            asm volatile("s_waitcnt vmcnt(0)" ::: "memory");
        } else {
            XB_SPIN(xb_ld(&bar[XB_XGEN(b.x)]) == gen, bar);
            __builtin_amdgcn_fence(__ATOMIC_ACQUIRE, "agent");
            asm volatile("s_waitcnt vmcnt(0)" ::: "memory");
        }
    }
    __syncthreads();
}

__device__ __forceinline__ void s_barrier_n(unsigned* cnt, unsigned target, unsigned* tmo) {
    asm volatile("s_waitcnt vmcnt(0)" ::: "memory");
    __syncthreads();
    if (threadIdx.x == 0) {
        __builtin_amdgcn_fence(__ATOMIC_RELEASE, "agent");
        asm volatile("s_waitcnt vmcnt(0)" ::: "memory");
        (void)xb_add(cnt, 1u);
        unsigned sp = 0;
        while (xb_ld(cnt) < target) { __builtin_amdgcn_s_sleep(1); if (++sp > (1u << 22)) { atomicAdd(tmo, 1u); break; } }
        __builtin_amdgcn_fence(__ATOMIC_ACQUIRE, "agent");
        asm volatile("s_waitcnt vmcnt(0)" ::: "memory");
    }
    __syncthreads();
}

constexpr int NWAVES = 8;
constexpr int N_PHASES = 2 + 4 * DEPTH;
constexpr int CW_BAR = 4096;
constexpr int CW_SBAR = 8192;
constexpr int NS = 8;
constexpr int RING_BYTES = 131072, LDSCTL_OFF = RING_BYTES, MISC_OFF = LDSCTL_OFF + 320, LDS_BYTES = 147456;
static_assert(wattn::L_END <= RING_BYTES && xattn::L_OST2 + 4 * 8192 <= RING_BYTES, "phase scratch inside the ring");

struct Args { const void* in[21]; float* out; unsigned char* ws; int ph_lo, ph_hi; };

__device__ __forceinline__ float wave_sum(float v) {
#pragma unroll
    for (int o = 1; o < 64; o <<= 1) v += __shfl_xor(v, o);
    return v;
}
__device__ __forceinline__ void tr_item64(const float* W, int ldw, int k0, int ncol0, const float* gk, bf16_t* WT, int ldd, int drow0, int dcol0, int lane) {
    const int n4 = lane & 15, kq = lane >> 4;
    const float* src = W + (size_t)(k0 + 16 * kq) * ldw + ncol0 + 4 * n4;
    f32x4 v[16];
#pragma unroll
    for (int i = 0; i < 16; ++i) v[i] = *(const f32x4*)(src + (size_t)i * ldw);
    if (gk) { const f32x4* gp = (const f32x4*)(gk + k0 + 16 * kq);
#pragma unroll
        for (int q = 0; q < 4; ++q) { const f32x4 gq = gp[q];
#pragma unroll
            for (int e = 0; e < 4; ++e) v[4 * q + e] = v[4 * q + e] * gq[e]; } }
    bf16_t* d = WT + (size_t)(drow0 + 4 * n4) * ldd + dcol0 + k0 + 16 * kq;
#pragma unroll
    for (int j = 0; j < 4; ++j) {
        u32x4 lo, hi;
        lo.x = cvt_pk_bf16(v[0][j], v[1][j]); lo.y = cvt_pk_bf16(v[2][j], v[3][j]); lo.z = cvt_pk_bf16(v[4][j], v[5][j]); lo.w = cvt_pk_bf16(v[6][j], v[7][j]);
        hi.x = cvt_pk_bf16(v[8][j], v[9][j]); hi.y = cvt_pk_bf16(v[10][j], v[11][j]); hi.z = cvt_pk_bf16(v[12][j], v[13][j]); hi.w = cvt_pk_bf16(v[14][j], v[15][j]);
        *(u32x4*)(d + (size_t)j * ldd) = lo; *(u32x4*)(d + (size_t)j * ldd + 8) = hi; }
}
__device__ __forceinline__ int in_srcmap(int n) {
    if (n < 1280) return n;
    if (n < 2304) { const int i = (n - 1280) >> 8, w = (n - 1280) & 255; return w < 128 ? 1792 + 128 * i + w : 2304 + 128 * i + (w - 128); }
    if (n < 3328) { const int i = (n - 2304) >> 8, w = (n - 2304) & 255; return w < 128 ? 1280 + 128 * i + w : 2816 + 128 * i + (w - 128); }
    return n;
}
__device__ __forceinline__ float row_to_bf16(const float* xrow, bf16_t* orow, int lane) {
    const f32x4* xr = (const f32x4*)xrow + lane; f32x4 v[4]; float s = 0.f;
#pragma unroll
    for (int j = 0; j < 4; ++j) { v[j] = xr[64 * j]; s += (v[j][0] * v[j][0] + v[j][1] * v[j][1]) + (v[j][2] * v[j][2] + v[j][3] * v[j][3]); }
    u32x2* o8 = (u32x2*)orow + lane;
#pragma unroll
    for (int j = 0; j < 4; ++j) { u32x2 w; w.x = cvt_pk_bf16(v[j][0], v[j][1]); w.y = cvt_pk_bf16(v[j][2], v[j][3]); o8[64 * j] = w; }
    return wave_sum(s);
}

__global__ void __launch_bounds__(NWAVES * 64, 2) fwd_kernel(Args args) {
    extern __shared__ __attribute__((aligned(16))) unsigned char lds[];
    LAS unsigned char* ldsl = (LAS unsigned char*)lds;
    volatile LAS unsigned* MISC = (volatile LAS unsigned*)(ldsl + MISC_OFF);
    const int tid = threadIdx.x, lane = tid & 63, wave = __builtin_amdgcn_readfirstlane(tid >> 6);
    const int G = gridDim.x; const int bx = blockIdx.x; const int vcu = (G % 8 == 0) ? (bx % 8) * (G / 8) + bx / 8 : bx;
    unsigned char* ws = args.ws; float* out = args.out;
    unsigned* ctl = (unsigned*)(ws + WS_CTL);
    for (int u = tid; u < (LDS_BYTES - LDSCTL_OFF) / 4; u += NWAVES * 64) ((LAS unsigned*)(ldsl + LDSCTL_OFF))[u] = 0u;
    __syncthreads();
    XcdBarrier bar = xcd_barrier_post(ctl + CW_BAR, MISC + 8);
    const int lo = args.ph_lo, hi = args.ph_hi;
#define IN(k) (lo <= (k) && (k) < hi)
#define SEAM(k) do { if (IN(k) && IN((k) + 1)) { xcd_barrier(bar); if (PROBE_DUP & 32) xcd_barrier(bar); } } while (0)

    const float* x_prompt = (const float*)args.in[0]; const float* x_sample = (const float*)args.in[1];
    const float* cache_attn_k = (const float*)args.in[2]; const float* cache_attn_v = (const float*)args.in[3]; const float* cache_conv = (const float*)args.in[4];
    const float* cache_mem_k = (const float*)args.in[5]; const float* cache_mem_v = (const float*)args.in[6]; const float* mem_prompt = (const float*)args.in[7];
    const float* norm_g = (const float*)args.in[8]; const float* w_in = (const float*)args.in[9]; const float* attn_sink = (const float*)args.in[10];
    const float* w_pa = (const float*)args.in[11]; const float* conv_w = (const float*)args.in[12]; const float* conv_b = (const float*)args.in[13];
    const float* w_pb = (const float*)args.in[14]; const float* mem_norm_g = (const float*)args.in[15]; const float* w_mk = (const float*)args.in[16];
    const float* w_mv = (const float*)args.in[17]; const float* w_px = (const float*)args.in[18]; const float* w_out = (const float*)args.in[19]; const float* final_g = (const float*)args.in[20];

    float* SS = (float*)(ws + WS_SS);
    bf16_t* WIN = (bf16_t*)(ws + WS_WIN); bf16_t* WP = (bf16_t*)(ws + WS_WP); bf16_t* WO = (bf16_t*)(ws + WS_WO); bf16_t* WM = (bf16_t*)(ws + WS_WM);
    bf16_t* XB = (bf16_t*)(ws + WS_XB); bf16_t* MEMB = (bf16_t*)(ws + WS_MEMB); float* RMEM = (float*)(ws + WS_RMEM);
    bf16_t* CKB = (bf16_t*)(ws + WS_CKB); bf16_t* CVB = (bf16_t*)(ws + WS_CVB); bf16_t* CMK = (bf16_t*)(ws + WS_CMK); bf16_t* CMV = (bf16_t*)(ws + WS_CMV);
    bf16_t* MK = (bf16_t*)(ws + WS_MK); bf16_t* MV = (bf16_t*)(ws + WS_MV); bf16_t* MG = (bf16_t*)(ws + WS_MG); bf16_t* ABX = (bf16_t*)(ws + WS_ABX);
    bf16_t* Qb = (bf16_t*)(ws + WS_Q); bf16_t* GA = (bf16_t*)(ws + WS_GA); bf16_t* Ub = (bf16_t*)(ws + WS_U); bf16_t* WBb = (bf16_t*)(ws + WS_WB);
    bf16_t* XQ = (bf16_t*)(ws + WS_XQ); bf16_t* GX = (bf16_t*)(ws + WS_GX); bf16_t* Kb = (bf16_t*)(ws + WS_K); bf16_t* Vb = (bf16_t*)(ws + WS_V);
    float* ZF = (float*)(ws + WS_ZF); bf16_t* ZB = (bf16_t*)(ws + WS_ZB);
    const int gw = vcu * NWAVES + wave, NGW = G * NWAVES;

#ifndef NO_P0
    for (int rep_ = 0; rep_ < ((PROBE_DUP & 16) ? 2 : 1); ++rep_)
    if (IN(0)) {
        constexpr int I_IN = 16 * 116, I_P = 3 * 8 * 16, I_O = 16 * 16, I_M = 2 * 16 * 8, I_L = I_IN + I_P + I_O + I_M;
        for (int it = gw; it < DEPTH * I_L; it += NGW) {
            const int l = it / I_L; int r = it - l * I_L;
            if (r < I_IN) { const int kb = r / 116, nb = r - kb * 116; tr_item64(w_in + (size_t)l * 1024 * NIN, NIN, 64 * kb, in_srcmap(64 * nb), norm_g + l * 1024, WIN + (size_t)l * NIN * 1024, 1024, 64 * nb, 0, lane); continue; }
            r -= I_IN;
            if (r < I_P) { const int br = r / 128, q = r - br * 128, kb = q >> 4, nb = q & 15; const float* W = (br == 0 ? w_pa : br == 1 ? w_pb : w_px) + (size_t)l * 512 * 1024;
                tr_item64(W, 1024, 64 * kb, 64 * nb, nullptr, WP + (size_t)l * 1024 * 1536, 1536, 64 * nb, br * 512, lane); continue; }
            r -= I_P;
            if (r < I_O) { const int kb = r >> 4, nb = r & 15; tr_item64(w_out + (size_t)l * 1024 * 1024, 1024, 64 * kb, 64 * nb, nullptr, WO + (size_t)l * 1024 * 1024, 1024, 64 * nb, 0, lane); continue; }
            r -= I_O;
            { const int kv = r >> 7, q = r & 127, kb = q >> 3, nb = q & 7; const float* W = (kv == 0 ? w_mk : w_mv) + (size_t)l * 1024 * 512;
              tr_item64(W, 512, 64 * kb, 64 * nb, mem_norm_g + l * 1024, WM + (size_t)l * 1024 * 1024, 1024, kv * 512 + 64 * nb, 0, lane); }
        }
        for (int m = gw; m < MT; m += NGW) { const float* xr = m < MP ? x_prompt + (size_t)m * 1024 : x_sample + (size_t)(m - MP) * 1024;
            const float s = row_to_bf16(xr, XB + (size_t)m * 1024, lane); if (lane == 0) SS[m] = s; }
        for (int m = gw; m < MEMROWS; m += NGW) { const float s = row_to_bf16(mem_prompt + (size_t)m * 1024, MEMB + (size_t)m * 1024, lane); if (lane == 0) RMEM[m] = rsqrtf(s * (1.0f / 1024.0f) + EPS); }
        {
            const size_t n1 = (size_t)DEPTH * DECB * 128 * 128 / 8, n2 = (size_t)DEPTH * DECB * 256 * 512 / 8, ntot = 2 * n1 + 2 * n2;
            for (size_t i = (size_t)vcu * 512 + tid; i < ntot; i += (size_t)G * 512) {
                const float* s; bf16_t* d; size_t j = i;
                if (j < n1) { s = cache_attn_k; d = CKB; } else if ((j -= n1) < n1) { s = cache_attn_v; d = CVB; } else if ((j -= n1) < n2) { s = cache_mem_k; d = CMK; } else { j -= n2; s = cache_mem_v; d = CMV; }
                const f32x4 a = *(const f32x4*)(s + j * 8), b = *(const f32x4*)(s + j * 8 + 4); st8(d + j * 8, a, b);
            }
        }
    }
#endif
    SEAM(0);

    for (int layer = 0; layer < DEPTH; ++layer) {
        const int pbase = 1 + 4 * layer;
#ifndef NO_A
        for (int rep_ = 0; rep_ < ((PROBE_DUP & 1) ? 2 : 1); ++rep_)
        if (IN(pbase)) {
            pg8::Gemm g{(const char*)XB, (const char*)(WIN + (size_t)layer * NIN * 1024), 1024, 1024, 1024, (long)((const char*)MEMB - (const char*)XB), (long)((const char*)WM - (const char*)(WIN + (size_t)layer * NIN * 1024))};
            EpiIn E{layer, SS + (size_t)layer * MT, RMEM, Qb, Kb, Vb, GA, Ub, WBb, XQ, GX, MG, MK, MV, out};
            if (bx >= G - NS) {
                const int si = bx - (G - NS);
                if (layer > 0) {
                    { pg8::Gemm gc{(const char*)ABX, (const char*)(WP + (size_t)(layer - 1) * 1024 * 1536), 1536, 1536, 512, 1024, 1024};
                      pg8::SchedS Sc{64, si, NS, 4, 3}; EpiBranch Ec{MG, ZB};
                      pg8::gemm_phase<EpiBranch, pg8::SchedS, true, true>(ldsl, gc, Sc, Ec); }
                    s_barrier_n(ctl + CW_SBAR, (unsigned)(NS * (2 * layer - 1)), ctl + CW_BAR + XB_TMO);
                    { pg8::Gemm gd{(const char*)ZB, (const char*)(WO + (size_t)(layer - 1) * 1024 * 1024), 1024, 1024, 1024, 0, 0};
                      pg8::SchedS Sd{64, si, NS, 4, 1};
                      EpiOut Ed{layer == 1 ? x_prompt : nullptr, x_sample, nullptr, XB, XB, SS + (size_t)layer * MT};
                      pg8::gemm_phase<EpiOut, pg8::SchedS, true, true>(ldsl, gd, Sd, Ed); }
                    s_barrier_n(ctl + CW_SBAR, (unsigned)(NS * (2 * layer)), ctl + CW_BAR + XB_TMO);
                }
                pg8::SchedS Sa{64, si, NS, NIN / 256, 1};
                pg8::gemm_phase<EpiIn, pg8::SchedS, true, true>(ldsl, g, Sa, E);
            } else {
                pg8::Sched S; S.init(MP, NIN, G - NS, bx, 1, layer == 0 ? 32 : 0);
                pg8::gemm_phase<EpiIn, pg8::Sched, true, true>(ldsl, g, S, E);
            }
        }
#endif
        SEAM(pbase);
        for (int rep_ = 0; rep_ < ((PROBE_DUP & 2) ? 2 : 1); ++rep_)
        if (IN(pbase + 1)) {
            const wattn::Ptrs WPt{Qb, Kb, Vb, CKB, CVB, GA, ABX, attn_sink};
#ifndef NO_W
            for (int k_ = 0; k_ < 3; ++k_) { const int ui = k_ < 2 ? vcu + k_ * G : (vcu >= 32 && vcu < 48 ? 512 + (vcu - 32) : -1); if (ui < 0 || (k_ < 2 && ui >= 512)) continue;
                if (ui < 512) { const int g_ = ui & 1, bc = ui >> 1; wattn::unit((char*)lds, WPt, layer, false, bc >> 7, bc & 127, g_); }
                else { const int s = ui - 512; wattn::unit((char*)lds, WPt, layer, true, s >> 1, 0, s & 1); }
            }
#endif
#ifndef NO_X
            for (int k_ = 0; k_ < 2; ++k_) { const int ui = k_ == 0 ? vcu : (vcu >= 48 && vcu < 80 ? 256 + (vcu - 48) : -1); if (ui < 0 || (k_ == 0 && ui >= 256)) continue;
                if (ui < 256) { const int h = ui & 3, rest = ui >> 2, qb = rest & 31, b = rest >> 5; const size_t row0 = (size_t)b * SEQ + (size_t)qb * 256;
                    xattn::body(XQ + row0 * 512 + h * 128, MK + ((size_t)layer * 512 + b * 256) * 512 + h * 128, MV + ((size_t)layer * 512 + b * 256) * 512 + h * 128,
                                GX + row0 * 512 + h * 128, ABX + row0 * 1536 + 1024 + h * 128, 8, (char*)lds); }
                else { const int s = ui - 256, h = s & 3, b = s >> 2; const size_t row0 = (size_t)MP + 32 * b; const size_t co = ((size_t)(layer * DECB + b) * 256) * 512 + h * 128;
                    xattn::body(XQ + row0 * 512 + h * 128, CMK + co, CMV + co, GX + row0 * 512 + h * 128, ABX + row0 * 1536 + 1024 + h * 128, 1, (char*)lds); }
            }
#endif
#ifndef NO_CV
            for (int k_ = 0; k_ < 2; ++k_) { const int it = k_ == 0 ? vcu : (vcu >= 80 && vcu < 84 ? 256 + (vcu - 80) : -1); if (it < 0 || (k_ == 0 && it >= 256)) continue;
                const int ch = lane * 8; const int row0 = it * 64 + wave * 8;
                const float* cw = conv_w + (size_t)layer * 3 * 512 + ch; const float* cb = conv_b + (size_t)layer * 512 + ch;
                float w0[8], w1[8], w2[8], bb_[8], um2[8], um1[8];
#pragma unroll
                for (int e = 0; e < 8; ++e) { w0[e] = cw[e]; w1[e] = cw[512 + e]; w2[e] = cw[1024 + e]; bb_[e] = cb[e]; um2[e] = 0.f; um1[e] = 0.f; }
                if (row0 < MP) { const int pos = row0 & (SEQ - 1);
                    if (pos >= 2) { const u32x4 a = *(const u32x4*)(Ub + (size_t)(row0 - 2) * 512 + ch), b = *(const u32x4*)(Ub + (size_t)(row0 - 1) * 512 + ch);
                        um2[0] = bf_lo(a.x); um2[1] = bf_hi(a.x); um2[2] = bf_lo(a.y); um2[3] = bf_hi(a.y); um2[4] = bf_lo(a.z); um2[5] = bf_hi(a.z); um2[6] = bf_lo(a.w); um2[7] = bf_hi(a.w);
                        um1[0] = bf_lo(b.x); um1[1] = bf_hi(b.x); um1[2] = bf_lo(b.y); um1[3] = bf_hi(b.y); um1[4] = bf_lo(b.z); um1[5] = bf_hi(b.z); um1[6] = bf_lo(b.w); um1[7] = bf_hi(b.w); }
                } else { const int rs = row0 - MP, t = rs & 31, b = rs >> 5;
                    if (t >= 2) { const u32x4 a = *(const u32x4*)(Ub + (size_t)(row0 - 2) * 512 + ch), b2 = *(const u32x4*)(Ub + (size_t)(row0 - 1) * 512 + ch);
                        um2[0] = bf_lo(a.x); um2[1] = bf_hi(a.x); um2[2] = bf_lo(a.y); um2[3] = bf_hi(a.y); um2[4] = bf_lo(a.z); um2[5] = bf_hi(a.z); um2[6] = bf_lo(a.w); um2[7] = bf_hi(a.w);
                        um1[0] = bf_lo(b2.x); um1[1] = bf_hi(b2.x); um1[2] = bf_lo(b2.y); um1[3] = bf_hi(b2.y); um1[4] = bf_lo(b2.z); um1[5] = bf_hi(b2.z); um1[6] = bf_lo(b2.w); um1[7] = bf_hi(b2.w); }
                    else { const float* cc = cache_conv + ((size_t)(layer * DECB + b) * 2) * 512 + ch;
#pragma unroll
                        for (int e = 0; e < 8; ++e) { um2[e] = cc[e]; um1[e] = cc[512 + e]; } }
                }
#pragma unroll
                for (int rr = 0; rr < 8; ++rr) { const size_t row = (size_t)row0 + rr;
                    const u32x4 uu = *(const u32x4*)(Ub + row * 512 + ch), wb = *(const u32x4*)(WBb + row * 512 + ch);
                    float uc[8] = {bf_lo(uu.x), bf_hi(uu.x), bf_lo(uu.y), bf_hi(uu.y), bf_lo(uu.z), bf_hi(uu.z), bf_lo(uu.w), bf_hi(uu.w)};
                    const float wv[8] = {bf_lo(wb.x), bf_hi(wb.x), bf_lo(wb.y), bf_hi(wb.y), bf_lo(wb.z), bf_hi(wb.z), bf_lo(wb.w), bf_hi(wb.w)};
                    float ov[8];
#pragma unroll
                    for (int e = 0; e < 8; ++e) { ov[e] = wv[e] * (w0[e] * um2[e] + w1[e] * um1[e] + w2[e] * uc[e] + bb_[e]); um2[e] = um1[e]; um1[e] = uc[e]; }
                    u32x4 w; w.x = cvt_pk_bf16(ov[0], ov[1]); w.y = cvt_pk_bf16(ov[2], ov[3]); w.z = cvt_pk_bf16(ov[4], ov[5]); w.w = cvt_pk_bf16(ov[6], ov[7]);
                    *(u32x4*)(ABX + row * 1536 + 512 + ch) = w; }
            }
#endif
        }
        SEAM(pbase + 1);
#ifndef NO_C
        for (int rep_ = 0; rep_ < ((PROBE_DUP & 4) ? 2 : 1); ++rep_)
        if (IN(pbase + 2)) {
            pg8::Gemm g{(const char*)ABX, (const char*)(WP + (size_t)layer * 1024 * 1536), 1536, 1536, 512, 1024, 1024};
            pg8::Sched S; S.init(MP, 1024, G, bx, 3, 0);
            EpiBranch E{MG, ZB};
            pg8::gemm_phase<EpiBranch, pg8::Sched, true, true>(ldsl, g, S, E);
        }
#endif
        SEAM(pbase + 2);
#ifndef NO_D
        for (int rep_ = ((PROBE_DUP & 8) ? 0 : 1); rep_ < 2; ++rep_)
        if (IN(pbase + 3)) {
            pg8::Gemm g{(const char*)ZB, (const char*)(WO + (size_t)layer * 1024 * 1024), 1024, 1024, 1024, 0, 0};
            pg8::Sched S; S.init(MP, 1024, G, bx, 1, 0);
            EpiOut E{layer == 0 ? x_prompt : nullptr, x_sample, layer == DEPTH - 1 ? (rep_ ? out : ZF) : nullptr, XB, rep_ ? XB : ABX, SS + (size_t)(rep_ ? layer + 1 : 6) * MT};
            pg8::gemm_phase<EpiOut, pg8::Sched, true, true>(ldsl, g, S, E);
        }
#endif
        SEAM(pbase + 3);
    }
    if (IN(N_PHASES - 1)) {
        const float* ssf = SS + (size_t)DEPTH * MT;
        int m0, m1, mstep;
        if (bx >= G - NS) {
            const int si = bx - (G - NS);
            { pg8::Gemm gc{(const char*)ABX, (const char*)(WP + (size_t)(DEPTH - 1) * 1024 * 1536), 1536, 1536, 512, 1024, 1024};
              pg8::SchedS Sc{64, si, NS, 4, 3}; EpiBranch Ec{MG, ZB};
              pg8::gemm_phase<EpiBranch, pg8::SchedS, true, true>(ldsl, gc, Sc, Ec); }
            s_barrier_n(ctl + CW_SBAR, (unsigned)(NS * (2 * DEPTH - 1)), ctl + CW_BAR + XB_TMO);
            { pg8::Gemm gd{(const char*)ZB, (const char*)(WO + (size_t)(DEPTH - 1) * 1024 * 1024), 1024, 1024, 1024, 0, 0};
              pg8::SchedS Sd{64, si, NS, 4, 1};
              EpiOut Ed{nullptr, nullptr, out, XB, XB, SS + (size_t)DEPTH * MT};
              pg8::gemm_phase<EpiOut, pg8::SchedS, true, true>(ldsl, gd, Sd, Ed); }
            s_barrier_n(ctl + CW_SBAR, (unsigned)(NS * (2 * DEPTH)), ctl + CW_BAR + XB_TMO);
            m0 = MP + si * NWAVES + wave; m1 = MT; mstep = NS * NWAVES;
        } else { m0 = bx * NWAVES + wave; m1 = MP; mstep = (G - NS) * NWAVES; }
        f32x4 gv[4];
#pragma unroll
        for (int j = 0; j < 4; ++j) gv[j] = ((const f32x4*)final_g)[lane + 64 * j];
        for (int m = m0; m < m1; m += mstep) { const float r = rsqrtf(ssf[m] * (1.0f / 1024.0f) + EPS); f32x4* xr = (f32x4*)(out + (size_t)m * 1024) + lane;
#pragma unroll
            for (int j = 0; j < 4; ++j) xr[64 * j] = xr[64 * j] * r * gv[j]; }
    }
#undef IN
#undef SEAM
}

extern "C" void kernel_launch(void* const* d_in, const int* in_sizes, int n_in, void* d_out, int out_size, void* d_ws, size_t ws_size, hipStream_t stream) {
    static int grid = 0;
    if (grid == 0) {
        if (n_in != 21 || in_sizes[0] != MP * DM || out_size != (int)O_TOTAL || ws_size < WS_END) {
            fprintf(stderr, "kernel_launch: shape mismatch: n_in %d in0 %d out %d ws %zu (need %zu); nothing launched\n", n_in, n_in > 0 ? in_sizes[0] : -1, out_size, ws_size, (size_t)WS_END); grid = -1; return; }
        int dev = 0, cus = 0, per_cu = 0;
        if (hipGetDevice(&dev) != hipSuccess || hipDeviceGetAttribute(&cus, hipDeviceAttributeMultiprocessorCount, dev) != hipSuccess) { fprintf(stderr, "kernel_launch: device query failed\n"); grid = -1; return; }
        if (hipFuncSetAttribute((const void*)fwd_kernel, hipFuncAttributeMaxDynamicSharedMemorySize, LDS_BYTES) != hipSuccess) { fprintf(stderr, "kernel_launch: hipFuncSetAttribute failed\n"); grid = -1; return; }
        if (hipOccupancyMaxActiveBlocksPerMultiprocessor(&per_cu, (const void*)fwd_kernel, NWAVES * 64, LDS_BYTES) != hipSuccess || per_cu < 1) {
            fprintf(stderr, "kernel_launch: occupancy query reports %d workgroups per CU; nothing launched\n", per_cu); (void)hipGetLastError(); grid = -1; return; }
        (void)hipGetLastError();
        grid = cus;
    }
    if (grid < 0) return;
    if (hipMemsetAsync((char*)d_ws + WS_CTL, 0, CTL_ZERO_BYTES, stream) != hipSuccess) { fprintf(stderr, "kernel_launch: memset failed\n"); return; }
    Args a{};
    for (int i = 0; i < 21; ++i) a.in[i] = d_in[i];
    a.out = (float*)d_out; a.ws = (unsigned char*)d_ws;
#if MK_N_LAUNCHES == 1
    a.ph_lo = 0; a.ph_hi = N_PHASES;
    hipLaunchKernelGGL(fwd_kernel, dim3(grid), dim3(NWAVES * 64), LDS_BYTES, stream, a);
#else
    for (int p = 0; p < N_PHASES; ++p) { a.ph_lo = p; a.ph_hi = p + 1; hipLaunchKernelGGL(fwd_kernel, dim3(grid), dim3(NWAVES * 64), LDS_BYTES, stream, a); }
#endif
    const hipError_t le = hipPeekAtLastError();
    if (le != hipSuccess) fprintf(stderr, "kernel_launch: launch failed: %s\n", hipGetErrorName(le));
}
```

```cpp
#include <hip/hip_runtime.h>
#include <hip/hip_bf16.h>
#include <cstdio>
#include <cstdint>

#ifndef MK_N_LAUNCHES
#define MK_N_LAUNCHES 1
#endif
#ifndef PROBE_DUP
#define PROBE_DUP 0
#endif

constexpr int DM = 1024, NBATCH = 2, SEQ = 8192, DEPTH = 4, DECB = 8, DECS = 32;
constexpr int MP = NBATCH * SEQ, MS = DECB * DECS, MT = MP + MS;
constexpr int NIN = 7424;
constexpr int NMEM = 256, MEMROWS = NBATCH * NMEM;
constexpr float EPS = 1e-6f;
constexpr float LOG2E = 1.4426950408889634f;
constexpr float QSCALE = 0.125f * LOG2E;

constexpr size_t O_YP = 0, O_YS = 16777216, O_KP = 17039360, O_VP = 17170432, O_CP = 17301504, O_MKP = 17309696, O_MVP = 18358272,
                 O_KS = 19406848, O_VS = 19537920, O_CS = 19668992, O_TOTAL = 19701760;

constexpr size_t MiB = 1u << 20;
constexpr size_t WS_CTL = 0, CTL_ZERO_BYTES = 1 * MiB;
constexpr size_t WS_SS = 256 * 1024;
constexpr size_t WS_WIN = 2 * MiB;
constexpr size_t WS_WP = 60 * MiB;
constexpr size_t WS_WO = 72 * MiB;
constexpr size_t WS_WM = 80 * MiB;
constexpr size_t WS_XB = 88 * MiB;
constexpr size_t WS_MEMB = 121 * MiB;
constexpr size_t WS_RMEM = 122 * MiB;
constexpr size_t WS_CKB = 123 * MiB, WS_CVB = 124 * MiB;
constexpr size_t WS_CMK = 125 * MiB, WS_CMV = 133 * MiB;
constexpr size_t WS_MK = 141 * MiB, WS_MV = 143 * MiB;
constexpr size_t WS_MG = 145 * MiB;
constexpr size_t WS_ABX = 243 * MiB;
constexpr size_t WS_Q = 292 * MiB, WS_GA = 309 * MiB, WS_U = 326 * MiB, WS_WB = 343 * MiB, WS_XQ = 360 * MiB, WS_GX = 377 * MiB;
constexpr size_t WS_K = 394 * MiB, WS_V = 399 * MiB;
constexpr size_t WS_ZF = 292 * MiB;
constexpr size_t WS_ZB = 404 * MiB;
constexpr size_t WS_END = 437 * MiB;
static_assert(WS_SS + 5 * (size_t)MT * 4 <= CTL_ZERO_BYTES, "SS inside memset region");
static_assert(WS_WIN + (size_t)4 * NIN * 1024 * 2 <= WS_WP && WS_XB + (size_t)MT * 1024 * 2 <= WS_MEMB && WS_MG + (size_t)MT * 3072 * 2 <= WS_ABX &&
              WS_ABX + (size_t)MT * 1536 * 2 <= WS_Q && WS_Q + (size_t)MT * 512 * 2 <= WS_GA && WS_K + (size_t)MT * 128 * 2 <= WS_V && WS_V + (size_t)MT * 128 * 2 <= WS_END &&
              WS_ZF + (size_t)MT * 1024 * 4 <= WS_K && WS_ZB + (size_t)MT * 1024 * 2 <= WS_END, "ws map");

typedef unsigned short bf16_t;
typedef short bf16x8 __attribute__((ext_vector_type(8)));
typedef short s16x4 __attribute__((ext_vector_type(4)));
typedef float f32x4 __attribute__((ext_vector_type(4)));
typedef float f32x16 __attribute__((ext_vector_type(16)));
typedef unsigned u32x4 __attribute__((ext_vector_type(4)));
typedef unsigned u32x2 __attribute__((ext_vector_type(2)));
#define LAS __attribute__((address_space(3)))
#define GAS __attribute__((address_space(1)))

__device__ __forceinline__ unsigned cvt_pk_bf16(float lo, float hi) { unsigned r; asm volatile("v_cvt_pk_bf16_f32 %0, %1, %2" : "=v"(r) : "v"(lo), "v"(hi)); return r; }
__device__ __forceinline__ float bf_lo(unsigned w) { return __uint_as_float(w << 16); }
__device__ __forceinline__ float bf_hi(unsigned w) { return __uint_as_float(w & 0xffff0000u); }
__device__ __forceinline__ float sigmoidf_(float x) { return __builtin_amdgcn_rcpf(1.f + __builtin_amdgcn_exp2f(-x * LOG2E)); }
__device__ __forceinline__ float siluf_(float x) { return x * sigmoidf_(x); }
__device__ __forceinline__ void st8(bf16_t* p, f32x4 v0, f32x4 v1) { u32x4 w; w.x = cvt_pk_bf16(v0[0], v0[1]); w.y = cvt_pk_bf16(v0[2], v0[3]); w.z = cvt_pk_bf16(v1[0], v1[1]); w.w = cvt_pk_bf16(v1[2], v1[3]); *(u32x4*)p = w; }

__device__ __forceinline__ void st8_wt(bf16_t* p, f32x4 v0, f32x4 v1) { u32x4 w; w.x = cvt_pk_bf16(v0[0], v0[1]); w.y = cvt_pk_bf16(v0[2], v0[3]); w.z = cvt_pk_bf16(v1[0], v1[1]); w.w = cvt_pk_bf16(v1[2], v1[3]);
    asm volatile("global_store_dwordx4 %0, %1, off sc1\n\ts_nop 1" :: "v"(p), "v"(w) : "memory"); }

namespace pg8 {
constexpr int BM = 256, BK = 64, HALF = 128, HTB = HALF * BK * 2, STAGE_BYTES = 8 * HTB, NXCD = 8, WGM = 8;
__host__ __device__ __forceinline__ int lds_byte(int r, int c) { const int st = (r >> 4) * 2 + (c >> 5), rr = r & 15, cc = c & 31, ob = rr * 64 + cc * 2; return st * 1024 + (ob ^ (((ob >> 9) & 1) << 5)); }
__host__ __device__ __forceinline__ void stage_rc(int b, int& R, int& C) { const int st = b / 1024, sb = b % 1024, swz = sb ^ (((sb >> 9) & 1) << 5); R = (st >> 1) * 16 + swz / 64; C = (st & 1) * 32 + (swz % 64) / 2; }
__host__ __device__ __forceinline__ int perm32(int rho) { const int n = rho >> 4, i = rho & 15; return 8 * (i >> 2) + 4 * n + (i & 3); }

struct Unit { int pm, pn, z; };
struct Gemm { const char* A; const char* B; int lda, ldb, K; long azstep, bzstep; };

struct Sched {
    int nM, nN, nwg, G, c, nz, nextra;
    __device__ void init(int M, int N, int G_, int c_, int nz_, int nextra_) { nM = M / BM; nN = N / BM; nwg = nM * nN; G = G_; c = c_; nz = nz_; nextra = nextra_; }
    __device__ bool next(int i, Unit& u) const {
        const int round = i / nz; u.z = i - round * nz;
        const long L = (long)round * G + c; if (L >= nwg + nextra) return false;
        if (L >= nwg) { const int j = (int)(L - nwg); u.pm = j & 1; u.pn = j >> 1; u.z = 1; return true; }
        int wgid = (int)L; { const int q = nwg / NXCD, r = nwg % NXCD, xcd = wgid % NXCD, off = wgid / NXCD; wgid = (xcd < r ? xcd * (q + 1) : r * (q + 1) + (xcd - r) * q) + off; }
        const int nig = WGM * nN, gid = wgid / nig, fm = gid * WGM, gsz = (nM - fm) < WGM ? (nM - fm) : WGM;
        u.pm = fm + ((wgid % nig) % gsz); u.pn = (wgid % nig) / gsz; return true;
    }
};

struct SchedS {
    int pm, pn0, pnstep, npn, nz;
    __device__ bool next(int i, Unit& u) const { const int round = i / nz; const int pn = pn0 + round * pnstep; if (pn >= npn) return false; u.pm = pm; u.pn = pn; u.z = i - round * nz; return true; }
};

template <class Epi, class SchedT, bool ALIGN_EPI, bool SP2>
__device__ __forceinline__ void gemm_phase(LAS unsigned char* lds, const Gemm g, const SchedT& S, const Epi& E) {
    int tid = threadIdx.x; asm volatile("" : "+v"(tid));
    const int wid = __builtin_amdgcn_readfirstlane(tid >> 6), lane = tid & 63, wr = wid >> 2, wc = wid & 3, fr = lane & 15, fq = lane >> 4;
    const int nt = g.K / BK;
    unsigned voffA[2], voffB[2];
#pragma unroll
    for (int i = 0; i < 2; ++i) { int R, C; stage_rc(tid * 16 + i * 8192, R, C); const int Rb = Epi::PERM ? ((R & ~31) + perm32(R & 31)) : R;
        voffA[i] = (unsigned)(R * g.lda + C) * 2u; voffB[i] = (unsigned)(Rb * g.ldb + C) * 2u; }
    const size_t kstep = (size_t)(BK * 2);
    const size_t hstepA = (size_t)HALF * g.lda * 2, hstepB = (size_t)HALF * g.ldb * 2;
    const size_t tstepA = 2 * hstepA, tstepB = 2 * hstepB;
    const unsigned ldsw = (unsigned)wid * 1024u;
    const int aoff = lds_byte(wr * 64 + fr, fq * 8), boff = lds_byte(wc * 32 + fr, fq * 8);
#define PG8_SA(b, h) (((b) * 2 + (h)) * HTB)
#define PG8_SB(b, h) ((4 + (b) * 2 + (h)) * HTB)
#define PG8_STAGE(bufoff, gbase, voff) do { _Pragma("unroll") for (int _i = 0; _i < 2; ++_i) \
        __builtin_amdgcn_global_load_lds((const unsigned*)((const char*)(gbase) + (voff)[_i]), (LAS unsigned*)(lds + (bufoff) + ldsw + _i * 8192), 16, 0, 0); } while (0)
#define PG8_LDA(dst, b, h) do { _Pragma("unroll") for (int m = 0; m < 4; ++m) _Pragma("unroll") for (int k = 0; k < 2; ++k) dst[m][k] = *(const LAS bf16x8*)(lds + PG8_SA(b, h) + aoff + m * 2048 + k * 1024); } while (0)
#define PG8_LDB(dst, b, h) do { _Pragma("unroll") for (int n = 0; n < 2; ++n) _Pragma("unroll") for (int k = 0; k < 2; ++k) dst[n][k] = *(const LAS bf16x8*)(lds + PG8_SB(b, h) + boff + n * 2048 + k * 1024); } while (0)
#define PG8_MMA(ai, bj, At, Bt) do { __builtin_amdgcn_s_setprio(1); _Pragma("unroll") for (int m = 0; m < 4; ++m) _Pragma("unroll") for (int n = 0; n < 2; ++n) _Pragma("unroll") for (int k = 0; k < 2; ++k) \
        acc[ai][bj][m][n] = __builtin_amdgcn_mfma_f32_16x16x32_bf16(Bt[n][k], At[m][k], acc[ai][bj][m][n], 0, 0, 0); __builtin_amdgcn_s_setprio(0); } while (0)
#define PG8_WAIT_V(n) asm volatile("s_waitcnt vmcnt(" #n ")" ::: "memory")
#define PG8_WAIT_L(n) asm volatile("s_waitcnt lgkmcnt(" #n ")" ::: "memory")
#define PG8_BAR __builtin_amdgcn_s_barrier()
#define PG8_SCHED __builtin_amdgcn_sched_barrier(0)
    Unit cur, nxt; int ui = 0;
    if (!S.next(0, cur)) return;
    f32x4 acc[2][2][4][2];
#pragma unroll
    for (int a = 0; a < 2; ++a)
#pragma unroll
        for (int b = 0; b < 2; ++b)
#pragma unroll
            for (int m = 0; m < 4; ++m)
#pragma unroll
                for (int n = 0; n < 2; ++n) acc[a][b][m][n] = (f32x4){0.f, 0.f, 0.f, 0.f};
    bf16x8 At[4][2], B0[2][2], B1[2][2];
    const char* cA = g.A + (size_t)cur.pm * tstepA + (long)cur.z * g.azstep; const char* cB = g.B + (size_t)cur.pn * tstepB + (long)cur.z * g.bzstep;
    if constexpr (SP2) {
        PG8_STAGE(PG8_SB(0, 0), cB, voffB); PG8_STAGE(PG8_SB(0, 1), cB + hstepB, voffB); PG8_STAGE(PG8_SA(0, 0), cA, voffA); PG8_STAGE(PG8_SA(0, 1), cA + hstepA, voffA);
        if (wr == 1) PG8_BAR;
        PG8_WAIT_V(2); PG8_BAR;
        PG8_STAGE(PG8_SB(1, 0), cB + kstep, voffB); PG8_STAGE(PG8_SA(1, 0), cA + kstep, voffA); PG8_STAGE(PG8_SB(1, 1), cB + hstepB + kstep, voffB);
        PG8_WAIT_V(6); PG8_BAR;
    } else {
        PG8_STAGE(PG8_SB(0, 0), cB, voffB); PG8_STAGE(PG8_SA(0, 0), cA, voffA); PG8_STAGE(PG8_SB(0, 1), cB + hstepB, voffB); PG8_STAGE(PG8_SA(0, 1), cA + hstepA, voffA);
        if (wr == 1) PG8_BAR;
        PG8_WAIT_V(4); PG8_BAR;
        PG8_STAGE(PG8_SB(1, 0), cB + kstep, voffB); PG8_STAGE(PG8_SA(1, 0), cA + kstep, voffA); PG8_STAGE(PG8_SB(1, 1), cB + hstepB + kstep, voffB);
        PG8_WAIT_V(6); PG8_BAR;
    }
    for (;;) {
        const bool has_next = S.next(ui + 1, nxt);
        const char* nA = has_next ? g.A + (size_t)nxt.pm * tstepA + (long)nxt.z * g.azstep : cA; const char* nB = has_next ? g.B + (size_t)nxt.pn * tstepB + (long)nxt.z * g.bzstep : cB;
        for (int t = 0; t < nt; t += 2) {
            const bool last = (t == nt - 2);
            const char* a1 = cA + (size_t)(t + 1) * kstep;
            const char* a2 = last ? nA : cA + (size_t)(t + 2) * kstep; const char* b2 = last ? nB : cB + (size_t)(t + 2) * kstep;
            const char* a3 = a2 + kstep; const char* b3 = b2 + kstep;
            if constexpr (SP2) {
            PG8_LDB(B0, 0, 0); PG8_LDB(B1, 0, 1); PG8_SCHED; PG8_LDA(At, 0, 0); PG8_STAGE(PG8_SA(1, 1), a1 + hstepA, voffA);
            PG8_WAIT_V(8); PG8_WAIT_L(0); PG8_BAR; PG8_MMA(0, 0, At, B0); PG8_MMA(0, 1, At, B1); PG8_BAR; PG8_SCHED;
            PG8_LDA(At, 0, 1); PG8_STAGE(PG8_SB(0, 0), b2, voffB); PG8_STAGE(PG8_SB(0, 1), b2 + hstepB, voffB); PG8_STAGE(PG8_SA(0, 0), a2, voffA);
            PG8_WAIT_V(8); PG8_WAIT_L(0); PG8_BAR; PG8_MMA(1, 0, At, B0); PG8_MMA(1, 1, At, B1); PG8_BAR; PG8_SCHED;
            PG8_LDB(B0, 1, 0); PG8_LDB(B1, 1, 1); PG8_SCHED; PG8_LDA(At, 1, 0); PG8_STAGE(PG8_SA(0, 1), a2 + hstepA, voffA);
            PG8_WAIT_V(8); PG8_WAIT_L(0); PG8_BAR; PG8_MMA(0, 0, At, B0); PG8_MMA(0, 1, At, B1); PG8_BAR; PG8_SCHED;
            PG8_LDA(At, 1, 1); PG8_STAGE(PG8_SB(1, 0), b3, voffB); PG8_STAGE(PG8_SB(1, 1), b3 + hstepB, voffB); PG8_STAGE(PG8_SA(1, 0), a3, voffA);
            PG8_WAIT_V(8); PG8_WAIT_L(0); PG8_BAR; PG8_MMA(1, 0, At, B0); PG8_MMA(1, 1, At, B1); PG8_BAR; PG8_SCHED;
            } else {
            PG8_LDB(B0, 0, 0); PG8_SCHED; PG8_LDA(At, 0, 0); PG8_STAGE(PG8_SA(1, 1), a1 + hstepA, voffA);
            PG8_WAIT_L(8); PG8_BAR; PG8_WAIT_L(0); PG8_MMA(0, 0, At, B0); PG8_BAR; PG8_SCHED;
            PG8_LDB(B1, 0, 1); PG8_STAGE(PG8_SB(0, 0), b2, voffB);
            PG8_BAR; PG8_WAIT_L(0); PG8_MMA(0, 1, At, B1); PG8_BAR;
            PG8_LDA(At, 0, 1); PG8_STAGE(PG8_SA(0, 0), a2, voffA);
            PG8_BAR; PG8_WAIT_L(0); PG8_MMA(1, 0, At, B0); PG8_BAR; PG8_SCHED;
            PG8_STAGE(PG8_SB(0, 1), b2 + hstepB, voffB);
            PG8_WAIT_V(6); PG8_BAR; PG8_MMA(1, 1, At, B1); PG8_BAR;
            PG8_LDB(B0, 1, 0); PG8_SCHED; PG8_LDA(At, 1, 0); PG8_STAGE(PG8_SA(0, 1), a2 + hstepA, voffA);
            PG8_WAIT_L(8); PG8_BAR; PG8_WAIT_L(0); PG8_MMA(0, 0, At, B0); PG8_BAR; PG8_SCHED;
            PG8_LDB(B1, 1, 1); PG8_STAGE(PG8_SB(1, 0), b3, voffB);
            PG8_BAR; PG8_WAIT_L(0); PG8_MMA(0, 1, At, B1); PG8_BAR;
            PG8_LDA(At, 1, 1); PG8_STAGE(PG8_SA(1, 0), a3, voffA);
            PG8_BAR; PG8_WAIT_L(0); PG8_MMA(1, 0, At, B0); PG8_BAR; PG8_SCHED;
            PG8_STAGE(PG8_SB(1, 1), b3 + hstepB, voffB);
            PG8_WAIT_V(6); PG8_BAR; PG8_MMA(1, 1, At, B1); PG8_BAR;
            }
        }
        if constexpr (ALIGN_EPI) { if (wr == 0) PG8_BAR; }
        if constexpr (Epi::PROBE2X) { if (PROBE_DUP & 64) (void)E(acc, cur, wr, wc, fr, fq); }
        const bool keep = E(acc, cur, wr, wc, fr, fq);
        if (!has_next) break;
        if (!keep) {
#pragma unroll
        for (int a = 0; a < 2; ++a)
#pragma unroll
            for (int b = 0; b < 2; ++b)
#pragma unroll
                for (int m = 0; m < 4; ++m)
#pragma unroll
                    for (int n = 0; n < 2; ++n) acc[a][b][m][n] = (f32x4){0.f, 0.f, 0.f, 0.f};
        }
        cur = nxt; cA = nA; cB = nB; ++ui;
        if constexpr (ALIGN_EPI) { if (wr == 1) PG8_BAR; }
    }
    PG8_WAIT_V(0);
    if constexpr (!ALIGN_EPI) { if (wr == 0) PG8_BAR; }
    PG8_BAR;
#undef PG8_SA
#undef PG8_SB
#undef PG8_STAGE
#undef PG8_LDA
#undef PG8_LDB
#undef PG8_MMA
#undef PG8_WAIT_V
#undef PG8_WAIT_L
#undef PG8_BAR
#undef PG8_SCHED
}
}

struct EpiIn {
    static constexpr bool PERM = true, PROBE2X = true;
    int layer; const float* ss; const float* rmem;
    bf16_t *Q, *Kb, *Vb, *GA, *U, *WB, *XQ, *GX, *MG, *MK, *MV; float* out;
    __device__ __forceinline__ bool operator()(f32x4 (&acc)[2][2][4][2], const pg8::Unit& u, int wr, int wc, int fr, int fq) const {
        int rowt = wr * 64 + fr, cl = wc * 32 + 8 * fq; asm volatile("" : "+v"(rowt), "+v"(cl));
        if (u.z == 1) {
            const int l = u.pn >> 2, q = u.pn & 3; bf16_t* dst = (q < 2 ? MK : MV) + (size_t)l * 512 * 512 + (q & 1) * 256 + cl; float* fo = out + (q < 2 ? O_MKP : O_MVP) + (size_t)l * 512 * 512 + (q & 1) * 256 + cl;
#pragma unroll
            for (int ai = 0; ai < 2; ++ai)
#pragma unroll
                for (int m = 0; m < 4; ++m) { const int row = u.pm * 256 + ai * 128 + rowt + m * 16; const float rs = rmem[row];
#pragma unroll
                    for (int bj = 0; bj < 2; ++bj) { const f32x4 v0 = acc[ai][bj][m][0] * rs, v1 = acc[ai][bj][m][1] * rs;
                        st8(dst + (size_t)row * 512 + bj * 128, v0, v1); *(f32x4*)(fo + (size_t)row * 512 + bj * 128) = v0; *(f32x4*)(fo + (size_t)row * 512 + bj * 128 + 4) = v1; }
                    asm volatile("" ::: "memory"); }
            return false;
        }
        const int pn = u.pn;
        bf16_t* o0; bf16_t* o1; int ld = 512, mode = 0; float sc = 1.f;
        if (pn < 2) { o0 = Q + pn * 256 + cl; o1 = o0 + 128; sc = QSCALE; }
        else if (pn == 2) { o0 = Kb + cl; o1 = Vb + cl; ld = 128; }
        else if (pn < 5) { o0 = GA + (pn - 3) * 256 + cl; o1 = o0 + 128; mode = 1; }
        else if (pn < 9) { o0 = U + (pn - 5) * 128 + cl; o1 = o0; mode = 3; }
        else if (pn < 13) { o0 = WB + (pn - 9) * 128 + cl; o1 = o0; mode = 4; }
        else if (pn < 15) { o0 = XQ + (pn - 13) * 256 + cl; o1 = o0 + 128; }
        else if (pn < 17) { o0 = GX + (pn - 15) * 256 + cl; o1 = o0 + 128; mode = 1; }
        else { o0 = MG + (pn - 17) * 256 + cl; o1 = o0 + 128; ld = 3072; mode = 2; }
        const float* ssr = ss + (size_t)u.pm * 256 + rowt;
#pragma unroll
        for (int ai = 0; ai < 2; ++ai)
#pragma unroll
            for (int m = 0; m < 4; ++m) {
                const int rt = ai * 128 + rowt + m * 16; const size_t roff = ((size_t)u.pm * 256 + rt) * ld; const float rs = rsqrtf(ssr[ai * 128 + m * 16] * (1.0f / 1024.0f) + EPS) * sc;
                f32x4 a00 = acc[ai][0][m][0] * rs, a01 = acc[ai][0][m][1] * rs, a10 = acc[ai][1][m][0] * rs, a11 = acc[ai][1][m][1] * rs;
                if (mode >= 3) {
                    if (mode == 3) { a00 = a00 * a10; a01 = a01 * a11; }
                    else {
#pragma unroll
                        for (int e = 0; e < 4; ++e) { a00[e] = a00[e] * siluf_(a10[e]); a01[e] = a01[e] * siluf_(a11[e]); } }
                    st8(o0 + roff, a00, a01);
                } else {
                    if (mode == 1) {
#pragma unroll
                        for (int e = 0; e < 4; ++e) { a00[e] = siluf_(a00[e]); a01[e] = siluf_(a01[e]); a10[e] = siluf_(a10[e]); a11[e] = siluf_(a11[e]); } }
                    else if (mode == 2) {
#pragma unroll
                        for (int e = 0; e < 4; ++e) { a00[e] = sigmoidf_(a00[e]); a01[e] = sigmoidf_(a01[e]); a10[e] = sigmoidf_(a10[e]); a11[e] = sigmoidf_(a11[e]); } }
                    st8(o0 + roff, a00, a01); st8(o1 + roff, a10, a11);
                }
                asm volatile("" ::: "memory");
            }
        const bool lastp = (u.pm == 31 || u.pm == 63), samp = (u.pm == 64);
        if ((pn == 2 || (pn >= 5 && pn < 9)) && (lastp || samp)) {
            const int bp = u.pm == 63 ? 1 : 0;
#pragma unroll
            for (int ai = 0; ai < 2; ++ai)
#pragma unroll
                for (int m = 0; m < 4; ++m) {
                    const int rt = ai * 128 + rowt + m * 16; const float rs = rsqrtf(ssr[ai * 128 + m * 16] * (1.0f / 1024.0f) + EPS);
                    const f32x4 a00 = acc[ai][0][m][0] * rs, a01 = acc[ai][0][m][1] * rs, a10 = acc[ai][1][m][0] * rs, a11 = acc[ai][1][m][1] * rs;
                    if (pn == 2) {
                        if (samp) { const size_t o = ((size_t)layer * 256 + rt) * 128 + cl; *(f32x4*)(out + O_KS + o) = a00; *(f32x4*)(out + O_KS + o + 4) = a01; *(f32x4*)(out + O_VS + o) = a10; *(f32x4*)(out + O_VS + o + 4) = a11; }
                        else if (ai == 1) { const size_t o = ((size_t)(layer * 2 + bp) * 128 + (rt - 128)) * 128 + cl;
                            *(f32x4*)(out + O_KP + o) = a00; *(f32x4*)(out + O_KP + o + 4) = a01; *(f32x4*)(out + O_VP + o) = a10; *(f32x4*)(out + O_VP + o + 4) = a11; }
                    } else {
                        const int ch = (pn - 5) * 128 + cl; const f32x4 u0 = a00 * a10, u1 = a01 * a11;
                        if (samp) { const int t = rt & 31, b = rt >> 5; if (t >= 30) { float* p = out + O_CS + ((size_t)(layer * 8 + b) * 2 + (t - 30)) * 512 + ch; *(f32x4*)p = u0; *(f32x4*)(p + 4) = u1; } }
                        else if (rt >= 254) { float* p = out + O_CP + ((size_t)(layer * 2 + bp) * 2 + (rt - 254)) * 512 + ch; *(f32x4*)p = u0; *(f32x4*)(p + 4) = u1; }
                    }
                    asm volatile("" ::: "memory");
                }
        }
        return false;
    }
};

struct EpiBranch {
    static constexpr bool PERM = true, PROBE2X = false;
    const bf16_t* MG; bf16_t* ZB;
    __device__ __forceinline__ bool operator()(f32x4 (&acc)[2][2][4][2], const pg8::Unit& u, int wr, int wc, int fr, int fq) const {
        int rowt = wr * 64 + fr, cl = wc * 32 + 8 * fq; asm volatile("" : "+v"(rowt), "+v"(cl));
        const bf16_t* gp = MG + ((size_t)u.pm * 256 + rowt) * 3072 + u.z * 1024 + u.pn * 256 + cl;
        if (u.z < 2) {
#pragma unroll
            for (int ai = 0; ai < 2; ++ai)
#pragma unroll
                for (int m = 0; m < 4; ++m) {
#pragma unroll
                    for (int bj = 0; bj < 2; ++bj) { const bf16_t* g = gp + (size_t)(ai * 128 + m * 16) * 3072 + bj * 128;
                        const u32x4 ga = *(const u32x4*)g, gb = *(const u32x4*)(g + 1024);
#define RAT(x, y) ((x) * __builtin_amdgcn_rcpf(__builtin_fmaxf((y), 1e-30f)))
                        f32x4& v0 = acc[ai][bj][m][0]; f32x4& v1 = acc[ai][bj][m][1];
                        v0[0] *= RAT(bf_lo(ga.x), bf_lo(gb.x)); v0[1] *= RAT(bf_hi(ga.x), bf_hi(gb.x)); v0[2] *= RAT(bf_lo(ga.y), bf_lo(gb.y)); v0[3] *= RAT(bf_hi(ga.y), bf_hi(gb.y));
                        v1[0] *= RAT(bf_lo(ga.z), bf_lo(gb.z)); v1[1] *= RAT(bf_hi(ga.z), bf_hi(gb.z)); v1[2] *= RAT(bf_lo(ga.w), bf_lo(gb.w)); v1[3] *= RAT(bf_hi(ga.w), bf_hi(gb.w));
#undef RAT
                    }
                    asm volatile("" ::: "memory"); }
            return true;
        }
        bf16_t* zp = ZB + ((size_t)u.pm * 256 + rowt) * 1024 + u.pn * 256 + cl;
#pragma unroll
        for (int ai = 0; ai < 2; ++ai)
#pragma unroll
            for (int m = 0; m < 4; ++m) {
#pragma unroll
                for (int bj = 0; bj < 2; ++bj) { const u32x4 gw = *(const u32x4*)(gp + (size_t)(ai * 128 + m * 16) * 3072 + bj * 128);
                    f32x4 v0 = acc[ai][bj][m][0], v1 = acc[ai][bj][m][1];
                    v0[0] *= bf_lo(gw.x); v0[1] *= bf_hi(gw.x); v0[2] *= bf_lo(gw.y); v0[3] *= bf_hi(gw.y);
                    v1[0] *= bf_lo(gw.z); v1[1] *= bf_hi(gw.z); v1[2] *= bf_lo(gw.w); v1[3] *= bf_hi(gw.w);
                    st8(zp + (size_t)(ai * 128 + m * 16) * 1024 + bj * 128, v0, v1); }
                asm volatile("" ::: "memory"); }
        return false;
    }
};

struct EpiOut {
    static constexpr bool PERM = true, PROBE2X = false;
    const float* xold_p; const float* xold_s; float* xnew; const bf16_t* XB; bf16_t* XBo; float* ssn;
    __device__ __forceinline__ bool operator()(f32x4 (&acc)[2][2][4][2], const pg8::Unit& u, int wr, int wc, int fr, int fq) const {
        int rowt = wr * 64 + fr, cl = wc * 32 + 8 * fq; asm volatile("" : "+v"(rowt), "+v"(cl));
#pragma unroll
        for (int ai = 0; ai < 2; ++ai)
#pragma unroll
            for (int m = 0; m < 4; ++m) { const size_t row = (size_t)u.pm * 256 + ai * 128 + rowt + m * 16; float sq = 0.f;
#pragma unroll
                for (int bj = 0; bj < 2; ++bj) { const int col = u.pn * 256 + bj * 128 + cl; f32x4 x0, x1;
                    if (xold_p) { const float* src = (row < (size_t)MP) ? xold_p + row * 1024 : xold_s + (row - MP) * 1024; x0 = *(const f32x4*)(src + col); x1 = *(const f32x4*)(src + col + 4); }
                    else { const u32x4 w = *(const u32x4*)(XB + row * 1024 + col); x0 = (f32x4){bf_lo(w.x), bf_hi(w.x), bf_lo(w.y), bf_hi(w.y)}; x1 = (f32x4){bf_lo(w.z), bf_hi(w.z), bf_lo(w.w), bf_hi(w.w)}; }
                    x0 += acc[ai][bj][m][0]; x1 += acc[ai][bj][m][1];
                    if (xnew) { *(f32x4*)(xnew + row * 1024 + col) = x0; *(f32x4*)(xnew + row * 1024 + col + 4) = x1; }
                    st8(XBo + row * 1024 + col, x0, x1);
                    sq += (x0[0] * x0[0] + x0[1] * x0[1]) + (x0[2] * x0[2] + x0[3] * x0[3]) + (x1[0] * x1[0] + x1[1] * x1[1]) + (x1[2] * x1[2] + x1[3] * x1[3]); }
                sq += __shfl_xor(sq, 16); sq += __shfl_xor(sq, 32);
                if (fq == 0) atomicAdd(ssn + row, sq); }
        return false;
    }
};

namespace wattn {
constexpr int SLOT = 8192;
constexpr int L_K = 0, L_V = 3 * SLOT, L_WS = 6 * SLOT, L_OST = L_WS + 8 * 256, L_END = L_OST + 8 * 4096;
__device__ __forceinline__ int crow(int r, int hi) { return (r & 3) + 8 * (r >> 2) + 4 * hi; }
struct Ptrs { const bf16_t *Q, *KB, *VB, *CKB, *CVB, *GA; bf16_t* ABX; const float* sink; };

__device__ __forceinline__ void pv(f32x16* o, int vb, bf16x8 pa0, bf16x8 pa1, bf16x8 pa2, bf16x8 pa3) {
#pragma unroll
    for (int d0 = 0; d0 < 2; ++d0) { s16x4 lo[4], hi[4];
#pragma unroll
        for (int ks = 0; ks < 4; ++ks) {
            asm volatile("ds_read_b64_tr_b16 %0,%1 offset:%c2" : "=&v"(lo[ks]) : "v"(vb), "i"(d0 * 4096 + ks * 1024) : "memory");
            asm volatile("ds_read_b64_tr_b16 %0,%1 offset:%c2" : "=&v"(hi[ks]) : "v"(vb), "i"(d0 * 4096 + ks * 1024 + 512) : "memory"); }
        asm volatile("s_waitcnt lgkmcnt(0)" ::: "memory"); __builtin_amdgcn_sched_barrier(0);
#define WPK(k) (bf16x8){lo[k][0], lo[k][1], lo[k][2], lo[k][3], hi[k][0], hi[k][1], hi[k][2], hi[k][3]}
        o[d0] = __builtin_amdgcn_mfma_f32_32x32x16_bf16(pa0, WPK(0), o[d0], 0, 0, 0);
        o[d0] = __builtin_amdgcn_mfma_f32_32x32x16_bf16(pa1, WPK(1), o[d0], 0, 0, 0);
        o[d0] = __builtin_amdgcn_mfma_f32_32x32x16_bf16(pa2, WPK(2), o[d0], 0, 0, 0);
        o[d0] = __builtin_amdgcn_mfma_f32_32x32x16_bf16(pa3, WPK(3), o[d0], 0, 0, 0);
#undef WPK
    }
}

__device__ __forceinline__ void unit(char* shm, const Ptrs& P, int layer, bool sample, int b, int c, int g) {
    int tid = threadIdx.x; asm volatile("" : "+v"(tid));
    const int lane = tid & 63, r32 = lane & 31, hi = lane >> 5; const int wid = __builtin_amdgcn_readfirstlane(tid >> 6);
    const int qrow0 = sample ? MP + 32 * b : b * SEQ + 64 * c;
    const int t0 = sample ? 0 : (c >= 2 ? 0 : 2 - c);
#pragma unroll
    for (int t = 0; t < 3; ++t) {
        if (t >= t0) {
            const bf16_t *kb, *vb; int clampr;
            if (sample && t < 2) { const size_t off = ((size_t)(layer * 8 + b) * 128 + 64 * t) * 128; kb = P.CKB + off; vb = P.CVB + off; clampr = 63; }
            else { const size_t row = sample ? (size_t)qrow0 : (size_t)(qrow0 - 128 + 64 * t); kb = P.KB + row * 128; vb = P.VB + row * 128; clampr = sample ? 31 : 63; }
            const int key = lane < clampr ? lane : clampr;
            const u32x4 kv = *(const u32x4*)(kb + (size_t)key * 128 + g * 64 + wid * 8);
            int vkey = 16 * (wid & 3) + (lane >> 2); vkey = vkey < clampr ? vkey : clampr; const int vd = (wid >> 2) * 32 + (lane & 3) * 8;
            const u32x4 vv = *(const u32x4*)(vb + (size_t)vkey * 128 + g * 64 + vd);
            *(u32x4*)(shm + L_K + t * SLOT + tid * 16) = kv;
            *(u32x4*)(shm + L_V + t * SLOT + tid * 16) = vv;
        }
    }
    __syncthreads();
    const int nrb = sample ? 1 : 2;
    if (wid < 4 * nrb) {
        const int j = sample ? wid : (wid >> 1), rb = sample ? 0 : (wid & 1);
        const int head = 4 * g + j, qi = rb * 32 + r32;
        const bf16_t* qp = P.Q + (size_t)(qrow0 + qi) * 512 + head * 64 + hi * 8;
        bf16x8 qr[4];
#pragma unroll
        for (int d0 = 0; d0 < 4; ++d0) qr[d0] = *(const bf16x8*)(qp + d0 * 16);
        f32x16 p[3][2];
#pragma unroll
        for (int t = 0; t < 3; ++t) {
            if (t >= t0) {
#pragma unroll
                for (int blk = 0; blk < 2; ++blk) { f32x16 a = {};
#pragma unroll
                    for (int d0 = 0; d0 < 4; ++d0) { const bf16x8 kf = *(const bf16x8*)(shm + L_K + t * SLOT + (2 * d0 + hi) * 1024 + (blk * 32 + r32) * 16);
                        a = __builtin_amdgcn_mfma_f32_32x32x16_bf16(kf, qr[d0], a, 0, 0, 0); }
                    p[t][blk] = a; }
            } else {
#pragma unroll
                for (int blk = 0; blk < 2; ++blk)
#pragma unroll
                    for (int r = 0; r < 16; ++r) p[t][blk][r] = -1e30f;
            }
        }
        const float slope2 = __builtin_amdgcn_exp2f(-(float)(head + 1)) * LOG2E;
        const float sink2 = P.sink[layer * 8 + head] * LOG2E;
        float basef = (float)(qi + 128 - 4 * hi); asm volatile("" : "+v"(basef));
        float mx = sink2;
#pragma unroll
        for (int t = 0; t < 3; ++t)
#pragma unroll
            for (int blk = 0; blk < 2; ++blk)
#pragma unroll
                for (int r = 0; r < 16; ++r) {
                    const float kc = (float)(64 * t + 32 * blk + (r & 3) + 8 * (r >> 2));
                    float s = p[t][blk][r] - slope2 * __builtin_fabsf(basef - kc);
                    if (sample && t == 2 && blk == 1) s = -1e30f;
                    if (t < t0) s = -1e30f;
                    p[t][blk][r] = s; mx = __builtin_fmaxf(mx, s);
                }
        { auto rr = __builtin_amdgcn_permlane32_swap(__float_as_uint(mx), __float_as_uint(mx), false, false); mx = __builtin_fmaxf(__uint_as_float(rr[0]), __uint_as_float(rr[1])); }
        float sum = 0.f;
#pragma unroll
        for (int t = 0; t < 3; ++t)
#pragma unroll
            for (int blk = 0; blk < 2; ++blk)
#pragma unroll
                for (int r = 0; r < 16; ++r) { const float e = __builtin_amdgcn_exp2f(p[t][blk][r] - mx); p[t][blk][r] = e; sum += e; }
        { auto rr = __builtin_amdgcn_permlane32_swap(__float_as_uint(sum), __float_as_uint(sum), false, false); sum = __uint_as_float(rr[0]) + __uint_as_float(rr[1]); }
        const float l = sum + __builtin_amdgcn_exp2f(sink2 - mx);
        f32x16 o[2]; o[0] = f32x16{}; o[1] = f32x16{};
        const int vb0 = (int)(unsigned)(uintptr_t)(shm + L_V) + ((lane >> 4) & 1) * 32 + (lane & 3) * 8 + (4 * hi + ((lane & 15) >> 2)) * 64;
#pragma unroll
        for (int t = 0; t < 3; ++t) {
            if (t >= t0) {
                u32x4 w0, w1, w2, w3;
#define PKW(P_, B_) cvt_pk_bf16(P_[B_], P_[B_ + 1])
                w0 = (u32x4){PKW(p[t][0], 0), PKW(p[t][0], 2), PKW(p[t][0], 4), PKW(p[t][0], 6)};
                w1 = (u32x4){PKW(p[t][0], 8), PKW(p[t][0], 10), PKW(p[t][0], 12), PKW(p[t][0], 14)};
                w2 = (u32x4){PKW(p[t][1], 0), PKW(p[t][1], 2), PKW(p[t][1], 4), PKW(p[t][1], 6)};
                w3 = (u32x4){PKW(p[t][1], 8), PKW(p[t][1], 10), PKW(p[t][1], 12), PKW(p[t][1], 14)};
#undef PKW
                pv(o, vb0 + t * SLOT, __builtin_bit_cast(bf16x8, w0), __builtin_bit_cast(bf16x8, w1), __builtin_bit_cast(bf16x8, w2), __builtin_bit_cast(bf16x8, w3));
            }
        }
        float* wsf = (float*)(shm + L_WS) + wid * 64;
        if (hi == 0) wsf[r32] = l;
        asm volatile("s_waitcnt lgkmcnt(0)" ::: "memory");
        bf16_t* stg = (bf16_t*)(shm + L_OST) + wid * 2048;
#pragma unroll
        for (int r = 0; r < 16; ++r) { const int orow = crow(r, hi); const float rl = __builtin_amdgcn_rcpf(wsf[orow]);
#pragma unroll
            for (int d0 = 0; d0 < 2; ++d0) { const float v = o[d0][r] * rl; stg[orow * 64 + d0 * 32 + r32] = (bf16_t)(cvt_pk_bf16(v, v) & 0xffffu); } }
        asm volatile("s_waitcnt lgkmcnt(0)" ::: "memory");
#pragma unroll
        for (int i = 0; i < 4; ++i) { const int row = i * 8 + (lane >> 3), ch = lane & 7;
            const u32x4 ov = *(const u32x4*)(stg + row * 64 + ch * 8);
            const size_t grow = (size_t)(qrow0 + rb * 32 + row);
            const u32x4 gv = *(const u32x4*)(P.GA + grow * 512 + head * 64 + ch * 8);
            u32x4 w;
            w.x = cvt_pk_bf16(bf_lo(ov.x) * bf_lo(gv.x), bf_hi(ov.x) * bf_hi(gv.x)); w.y = cvt_pk_bf16(bf_lo(ov.y) * bf_lo(gv.y), bf_hi(ov.y) * bf_hi(gv.y));
            w.z = cvt_pk_bf16(bf_lo(ov.z) * bf_lo(gv.z), bf_hi(ov.z) * bf_hi(gv.z)); w.w = cvt_pk_bf16(bf_lo(ov.w) * bf_lo(gv.w), bf_hi(ov.w) * bf_hi(gv.w));
            *(u32x4*)(P.ABX + grow * 1536 + head * 64 + ch * 8) = w; }
    }
    __syncthreads();
}
}

namespace xattn {
constexpr int D = 128, NW = 8, QBLK = 32, KVBLK = 64;
constexpr float SCALE = 0.088388347648318440f;
constexpr float THR = 0.f;
constexpr int LDQ = 512, LDK = 512;
constexpr size_t SHM_V = KVBLK * D * 2, SHM_K = KVBLK * D * 2, SHM_ATTN = 2 * SHM_V + 2 * SHM_K + NW * 64 * 4;
constexpr int L_OST2 = (int)SHM_ATTN;
#define KSWZ(row, colB) ((row) * 256 + ((colB) ^ (((row) & 7) << 4)))
#define SBAR() __builtin_amdgcn_sched_barrier(0)
__device__ __forceinline__ int crow(int r, int hi) { return (r & 3) + 8 * (r >> 2) + 4 * hi; }
__device__ __forceinline__ void partialSM(f32x16& p0, f32x16& p1, float& m_reg, float& mn, float& alpha) {
    constexpr float C = SCALE * 1.4426950408889634f;
    float pmax = p0[0];
#pragma unroll
    for (int r = 1; r < 16; ++r) pmax = fmaxf(pmax, p0[r]);
#pragma unroll
    for (int r = 0; r < 16; ++r) pmax = fmaxf(pmax, p1[r]);
    { auto rr = __builtin_amdgcn_permlane32_swap(__float_as_uint(pmax), __float_as_uint(pmax), false, false); pmax = fmaxf(__uint_as_float(rr[0]), __uint_as_float(rr[1])); }
    if (__builtin_expect(__all(pmax - m_reg <= THR / SCALE), 1)) { mn = m_reg; alpha = 1.f; }
    else { mn = fmaxf(m_reg, pmax); alpha = __builtin_amdgcn_exp2f((m_reg - mn) * C); m_reg = mn; }
    const float mnC = -mn * C;
#pragma unroll
    for (int r = 0; r < 16; ++r) p0[r] = fmaf(p0[r], C, mnC);
#pragma unroll
    for (int r = 0; r < 16; ++r) p1[r] = fmaf(p1[r], C, mnC);
#pragma unroll
    for (int r = 0; r < 16; ++r) p0[r] = __builtin_amdgcn_exp2f(p0[r]);
}
__device__ __forceinline__ void finishSM(f32x16& p0, f32x16& p1, float alpha, float& l_reg, bf16x8& pa0, bf16x8& pa1, bf16x8& pa2, bf16x8& pa3) {
#pragma unroll
    for (int r = 0; r < 16; ++r) p1[r] = __builtin_amdgcn_exp2f(p1[r]);
    float ps = 0;
#pragma unroll
    for (int r = 0; r < 16; ++r) ps += p0[r];
#pragma unroll
    for (int r = 0; r < 16; ++r) ps += p1[r];
    { auto rr = __builtin_amdgcn_permlane32_swap(__float_as_uint(ps), __float_as_uint(ps), false, false); ps = __uint_as_float(rr[0]) + __uint_as_float(rr[1]); }
    l_reg = l_reg * alpha + ps;
#define PK4(P, BASE, OUT) do { unsigned a0 = cvt_pk_bf16(P[BASE + 0], P[BASE + 1]), a1 = cvt_pk_bf16(P[BASE + 2], P[BASE + 3]);   \
    unsigned b0 = cvt_pk_bf16(P[BASE + 4], P[BASE + 5]), b1 = cvt_pk_bf16(P[BASE + 6], P[BASE + 7]);                              \
    auto r0 = __builtin_amdgcn_permlane32_swap(a0, b0, false, false); auto r1 = __builtin_amdgcn_permlane32_swap(a1, b1, false, false); \
    u32x4 w = {r0[0], r1[0], r0[1], r1[1]}; OUT = __builtin_bit_cast(bf16x8, w); } while (0)
    PK4(p0, 0, pa0); PK4(p0, 8, pa1); PK4(p1, 0, pa2); PK4(p1, 8, pa3);
#undef PK4
}
__device__ __forceinline__ void qkt(f32x16& p0, f32x16& p1, const char* Ks, const bf16x8* qr, int r32, int hi) {
    p0 = f32x16{}; p1 = f32x16{};
#pragma unroll
    for (int d0 = 0; d0 < 8; ++d0) { const int cb = (d0 * 16 + hi * 8) * 2;
        const bf16x8 b0 = *reinterpret_cast<const bf16x8*>(Ks + KSWZ(r32, cb));
        const bf16x8 b1 = *reinterpret_cast<const bf16x8*>(Ks + KSWZ(32 + r32, cb));
        p0 = __builtin_amdgcn_mfma_f32_32x32x16_bf16(b0, qr[d0], p0, 0, 0, 0);
        p1 = __builtin_amdgcn_mfma_f32_32x32x16_bf16(b1, qr[d0], p1, 0, 0, 0); }
}
__device__ __forceinline__ int v_st(int k, int c) { const int kk = (k & ~0xC) | ((k & 4) << 1) | ((k & 8) >> 1); return ((kk >> 3) * 4 + (c >> 5)) * 512 + ((kk & 7) * 32 + (c & 31)) * 2; }
__device__ __forceinline__ int v_rd_base(int lane) { return ((lane & 3) << 3) | (((lane >> 2) & 3) << 6) | (((lane >> 4) & 1) << 5) | (((lane >> 5) & 1) << 8); }
constexpr int v_rd_off(int d0, int ks, int half) { return d0 * 512 + ks * 4096 + half * 2048; }
template <int OFF> __device__ __forceinline__ s16x4 tr_read(int vb) { s16x4 r; asm volatile("ds_read_b64_tr_b16 %0, %1 offset:%2" : "=&v"(r) : "v"(vb), "i"(OFF) : "memory"); return r; }
template <int D0> __device__ __forceinline__ void pv_one(f32x16& od, int vb, bf16x8 pa0, bf16x8 pa1, bf16x8 pa2, bf16x8 pa3) {
    const s16x4 l0 = tr_read<v_rd_off(D0, 0, 0)>(vb), h0 = tr_read<v_rd_off(D0, 0, 1)>(vb), l1 = tr_read<v_rd_off(D0, 1, 0)>(vb), h1 = tr_read<v_rd_off(D0, 1, 1)>(vb);
    const s16x4 l2 = tr_read<v_rd_off(D0, 2, 0)>(vb), h2 = tr_read<v_rd_off(D0, 2, 1)>(vb), l3 = tr_read<v_rd_off(D0, 3, 0)>(vb), h3 = tr_read<v_rd_off(D0, 3, 1)>(vb);
    asm volatile("s_waitcnt lgkmcnt(0)" ::: "memory"); SBAR();
#define XPK(L, H) (bf16x8){L[0], L[1], L[2], L[3], H[0], H[1], H[2], H[3]}
    od = __builtin_amdgcn_mfma_f32_32x32x16_bf16(pa0, XPK(l0, h0), od, 0, 0, 0);
    od = __builtin_amdgcn_mfma_f32_32x32x16_bf16(pa1, XPK(l1, h1), od, 0, 0, 0);
    od = __builtin_amdgcn_mfma_f32_32x32x16_bf16(pa2, XPK(l2, h2), od, 0, 0, 0);
    od = __builtin_amdgcn_mfma_f32_32x32x16_bf16(pa3, XPK(l3, h3), od, 0, 0, 0);
#undef XPK
}
__device__ __forceinline__ void pv_d0(f32x16* o, int vb, bf16x8 pa0, bf16x8 pa1, bf16x8 pa2, bf16x8 pa3) {
    pv_one<0>(o[0], vb, pa0, pa1, pa2, pa3); pv_one<1>(o[1], vb, pa0, pa1, pa2, pa3); pv_one<2>(o[2], vb, pa0, pa1, pa2, pa3); pv_one<3>(o[3], vb, pa0, pa1, pa2, pa3);
}
__device__ __forceinline__ void body(const bf16_t* __restrict__ Qb, const bf16_t* __restrict__ Kh, const bf16_t* __restrict__ Vh, const bf16_t* __restrict__ Gb, bf16_t* __restrict__ Ob, int nvw, char* lds) {
    constexpr int seq = 256;
    int tid = threadIdx.x; asm volatile("" : "+v"(tid));
    const int wid = __builtin_amdgcn_readfirstlane(tid >> 6), lane = tid & 63, r32 = lane & 31, hi = lane >> 5;
    const int widq = wid < nvw ? wid : 0;
    char* V_lds = lds; char* K_lds = lds + 2 * SHM_V;
    float* ws = (float*)(lds + 2 * SHM_V + 2 * SHM_K) + wid * 64; float* li_l = ws; float* al_l = ws + 32;
    float m_reg = -1e30f, l_reg = 0; f32x16 o[4] = {}; bf16x8 qr[8];
    const bf16_t* Qw = Qb + (long)(widq * QBLK + r32) * LDQ + hi * 8;
#pragma unroll
    for (int d0 = 0; d0 < 8; ++d0) qr[d0] = *reinterpret_cast<const bf16x8*>(Qw + d0 * 16);
    const int sr = tid >> 4, sc = (tid & 15) * 8, vst0 = v_st(sr, sc), vst1 = v_st(32 + sr, sc);
    const int vb0 = (int)(unsigned)(uintptr_t)V_lds + v_rd_base(lane);
    struct { bf16x8 vs0, vs1, ks0, ks1; } sr_[2];
#define SLOAD(i, k0) do { sr_[i].vs0 = *reinterpret_cast<const bf16x8*>(&Vh[(long)((k0) + sr) * LDK + sc]); sr_[i].vs1 = *reinterpret_cast<const bf16x8*>(&Vh[(long)((k0) + 32 + sr) * LDK + sc]); \
    sr_[i].ks0 = *reinterpret_cast<const bf16x8*>(&Kh[(long)((k0) + sr) * LDK + sc]); sr_[i].ks1 = *reinterpret_cast<const bf16x8*>(&Kh[(long)((k0) + 32 + sr) * LDK + sc]); } while (0)
#define SWRITE(b, i) do { *(bf16x8*)(V_lds + (b) * SHM_V + vst0) = sr_[i].vs0;          \
    *(bf16x8*)(V_lds + (b) * SHM_V + vst1) = sr_[i].vs1; const int kc = sc * 2;               \
    *(bf16x8*)(K_lds + (b) * SHM_K + KSWZ(sr, kc)) = sr_[i].ks0;                       \
    *(bf16x8*)(K_lds + (b) * SHM_K + KSWZ(32 + sr, kc)) = sr_[i].ks1; } while (0)
#define SWAIT() asm volatile("s_waitcnt vmcnt(4)" ::: "memory")
#define RESC(a) do { if (__any((a) < 1.f)) { if (hi == 0) al_l[r32] = (a); asm volatile("s_waitcnt lgkmcnt(0)" ::: "memory"); \
    _Pragma("unroll") for (int d = 0; d < 4; ++d) _Pragma("unroll") for (int r = 0; r < 16; ++r) o[d][r] *= al_l[crow(r, hi)]; } } while (0)
    f32x16 pA0, pA1, pB0, pB1; float mnA, mnB, alA, alB; bf16x8 pa0, pa1, pa2, pa3; constexpr int NT = seq / KVBLK;
    constexpr int SE = 0, SO = 1;
    SLOAD(SE, 0); asm volatile("s_waitcnt vmcnt(0)" ::: "memory"); SWRITE(0, SE); __syncthreads();
    qkt(pA0, pA1, K_lds, qr, r32, hi); partialSM(pA0, pA1, m_reg, mnA, alA);
    SLOAD(SO, KVBLK); if (2 < NT) SLOAD(SE, 2 * KVBLK);
    SWAIT(); SWRITE(1, SO); __syncthreads();
#pragma unroll 1
    for (int j = 1; j + 1 < NT; j += 2) {
        SBAR(); qkt(pB0, pB1, K_lds + SHM_K, qr, r32, hi);
        finishSM(pA0, pA1, alA, l_reg, pa0, pa1, pa2, pa3); SBAR();
        SLOAD(SO, (j + 2) * KVBLK); SBAR();
        pv_d0(o, vb0, pa0, pa1, pa2, pa3); partialSM(pB0, pB1, m_reg, mnB, alB);
        __syncthreads(); SWAIT(); SWRITE(0, SE);
        RESC(alB); __syncthreads();
        SBAR(); qkt(pA0, pA1, K_lds, qr, r32, hi);
        finishSM(pB0, pB1, alB, l_reg, pa0, pa1, pa2, pa3); SBAR();
        if (j + 3 < NT) SLOAD(SE, (j + 3) * KVBLK); SBAR();
        pv_d0(o, vb0 + (int)SHM_V, pa0, pa1, pa2, pa3); partialSM(pA0, pA1, m_reg, mnA, alA);
        __syncthreads(); SWAIT(); SWRITE(1, SO);
        RESC(alA); __syncthreads();
    }
    SBAR(); qkt(pB0, pB1, K_lds + SHM_K, qr, r32, hi);
    finishSM(pA0, pA1, alA, l_reg, pa0, pa1, pa2, pa3); SBAR();
    pv_d0(o, vb0, pa0, pa1, pa2, pa3); partialSM(pB0, pB1, m_reg, mnB, alB);
    __syncthreads(); RESC(alB);
    finishSM(pB0, pB1, alB, l_reg, pa0, pa1, pa2, pa3); SBAR();
    pv_d0(o, vb0 + (int)SHM_V, pa0, pa1, pa2, pa3);
    if (hi == 0) li_l[r32] = l_reg; asm volatile("s_waitcnt lgkmcnt(0)" ::: "memory");
    bf16_t* stg = (bf16_t*)(wid < 4 ? K_lds + wid * 8192 : lds + L_OST2 + (wid - 4) * 8192);
#pragma unroll
    for (int r = 0; r < 16; ++r) { const int orow = crow(r, hi); const float rl = __builtin_amdgcn_rcpf(li_l[orow]);
#pragma unroll
        for (int d0 = 0; d0 < 4; ++d0) { const float v = o[d0][r] * rl; stg[orow * 128 + d0 * 32 + r32] = (bf16_t)(cvt_pk_bf16(v, v) & 0xffffu); } }
    asm volatile("s_waitcnt lgkmcnt(0)" ::: "memory");
    if (wid < nvw) {
#pragma unroll
        for (int i = 0; i < 8; ++i) { const int row = i * 4 + (lane >> 4), ch = lane & 15;
            const u32x4 ov = *(const u32x4*)(stg + row * 128 + ch * 8);
            const long grow = (long)(wid * QBLK + row);
            const u32x4 gv = *(const u32x4*)(Gb + grow * 512 + ch * 8);
            u32x4 w;
            w.x = cvt_pk_bf16(bf_lo(ov.x) * bf_lo(gv.x), bf_hi(ov.x) * bf_hi(gv.x)); w.y = cvt_pk_bf16(bf_lo(ov.y) * bf_lo(gv.y), bf_hi(ov.y) * bf_hi(gv.y));
            w.z = cvt_pk_bf16(bf_lo(ov.z) * bf_lo(gv.z), bf_hi(ov.z) * bf_hi(gv.z)); w.w = cvt_pk_bf16(bf_lo(ov.w) * bf_lo(gv.w), bf_hi(ov.w) * bf_hi(gv.w));
            *(u32x4*)(Ob + grow * 1536 + ch * 8) = w; }
    }
    __syncthreads();
#undef SLOAD
#undef SWRITE
#undef SWAIT
#undef RESC
}
#undef KSWZ
#undef SBAR
}

typedef GAS unsigned gu32;
#define RLX_AGENT __ATOMIC_RELAXED, __HIP_MEMORY_SCOPE_AGENT
#define XB_TMO      128
#define XB_XCNT(j)  (256  + 64 * (j))
#define XB_XSUB(j)  (1280 + 64 * (j))
#define XB_XGEN(j)  (2304 + 64 * (j))
#define XB_TOP      3328
#define XB_TOPGEN   3392
#define XCD_BAR_WORDS 3456
#define XB_SPIN_CAP (1u << 18)
__device__ __forceinline__ unsigned xb_ld(unsigned* p)              { return __hip_atomic_load(p, __ATOMIC_RELAXED, __HIP_MEMORY_SCOPE_AGENT); }
__device__ __forceinline__ unsigned xb_add(unsigned* p, unsigned v) { return __hip_atomic_fetch_add(p, v, __ATOMIC_RELAXED, __HIP_MEMORY_SCOPE_AGENT); }
__device__ __forceinline__ unsigned xb_xcc_id() { return (unsigned)__builtin_amdgcn_s_getreg((3 << 11) | 20) & 0xFu; }
#define XB_SPIN(cond, bar) do { unsigned _sp = 0; while (cond) { __builtin_amdgcn_s_sleep(1); \
    if ((++_sp & 255u) == 0u) { if (xb_ld(&(bar)[XB_TMO])) break; if (_sp > XB_SPIN_CAP) { atomicAdd(&(bar)[XB_TMO], 1u); break; } } } } while (0)
struct XcdBarrier { unsigned* bar; unsigned x; volatile LAS unsigned* st; };
__device__ __forceinline__ XcdBarrier xcd_barrier_post(unsigned* bar, volatile LAS unsigned* st) {
    XcdBarrier b; b.bar = bar; b.x = xb_xcc_id(); b.st = st;
    if (threadIdx.x == 0) (void)xb_add(&bar[XB_XCNT(b.x)], 1u);
    return b;
}
__device__ __forceinline__ void xcd_barrier_complete(unsigned* bar, unsigned x, unsigned& nloc, unsigned& nx) {
    const unsigned G = gridDim.x * gridDim.y * gridDim.z;
    unsigned sum, cnt, mine, sp = 0u;
    for (;;) {
        sum = 0u; cnt = 0u; mine = 0u;
#pragma unroll
        for (unsigned j = 0; j < 16; ++j) { const unsigned c = xb_ld(&bar[XB_XCNT(j)]); sum += c; cnt += (c > 0u) ? 1u : 0u; mine = (j == x) ? c : mine; }
        if (sum == G) break;
        __builtin_amdgcn_s_sleep(1);
        if ((++sp & 255u) == 0u) { if (xb_ld(&bar[XB_TMO])) break; if (sp > XB_SPIN_CAP) { atomicAdd(&bar[XB_TMO], 1u); break; } }
    }
    nloc = mine > 0u ? mine : 1u; nx = cnt > 0u ? cnt : 1u;
}
__device__ __forceinline__ void xcd_barrier(const XcdBarrier& b) {
    asm volatile("s_waitcnt vmcnt(0)" ::: "memory");
    __syncthreads();
    if (threadIdx.x == 0) {
        unsigned* bar = b.bar;
        __builtin_amdgcn_s_waitcnt(0);
        unsigned nloc = b.st[0], nx = b.st[1];
        if (nloc == 0u) { xcd_barrier_complete(bar, b.x, nloc, nx); b.st[0] = nloc; b.st[1] = nx; }
        const unsigned old = xb_add(&bar[XB_XSUB(b.x)], 1u);
        const unsigned gen = old / nloc;
        if (old + 1u == (gen + 1u) * nloc) {
            __builtin_amdgcn_fence(__ATOMIC_RELEASE, "agent");
            asm volatile("s_waitcnt vmcnt(0)" ::: "memory");
            const unsigned og = xb_add(&bar[XB_TOP], 1u);
            const unsigned tg = og / nx;
            if (og + 1u == (tg + 1u) * nx) xb_add(&bar[XB_TOPGEN], 1u);
            else XB_SPIN(xb_ld(&bar[XB_TOPGEN]) == tg, bar);
            __builtin_amdgcn_fence(__ATOMIC_ACQUIRE, "agent");
            xb_add(&bar[XB_XGEN(b.x)], 1u);
            asm volatile("s_waitcnt vmcnt(0)" ::: "memory");
        } else {
            XB_SPIN(xb_ld(&bar[XB_XGEN(b.x)]) == gen, bar);
            __builtin_amdgcn_fence(__ATOMIC_ACQUIRE, "agent");
            asm volatile("s_waitcnt vmcnt(0)" ::: "memory");
        }
    }
    __syncthreads();
}

__device__ __forceinline__ void s_barrier_n(unsigned* cnt, unsigned target, unsigned* tmo) {
    asm volatile("s_waitcnt vmcnt(0)" ::: "memory");
    __syncthreads();
    if (threadIdx.x == 0) {
        __builtin_amdgcn_fence(__ATOMIC_RELEASE, "agent");
        asm volatile("s_waitcnt vmcnt(0)" ::: "memory");
        (void)xb_add(cnt, 1u);
        unsigned sp = 0;
        while (xb_ld(cnt) < target) { __builtin_amdgcn_s_sleep(1); if (++sp > (1u << 22)) { atomicAdd(tmo, 1u); break; } }
        __builtin_amdgcn_fence(__ATOMIC_ACQUIRE, "agent");
        asm volatile("s_waitcnt vmcnt(0)" ::: "memory");
    }
    __syncthreads();
}

constexpr int NWAVES = 8;
constexpr int N_PHASES = 2 + 4 * DEPTH;
constexpr int CW_BAR = 4096;
constexpr int CW_SBAR = 8192;
constexpr int NS = 8;
constexpr int RING_BYTES = 131072, LDSCTL_OFF = RING_BYTES, MISC_OFF = LDSCTL_OFF + 320, LDS_BYTES = 147456;
static_assert(wattn::L_END <= RING_BYTES && xattn::L_OST2 + 4 * 8192 <= RING_BYTES, "phase scratch inside the ring");

struct Args { const void* in[21]; float* out; unsigned char* ws; int ph_lo, ph_hi; };

__device__ __forceinline__ float wave_sum(float v) {
#pragma unroll
    for (int o = 1; o < 64; o <<= 1) v += __shfl_xor(v, o);
    return v;
}
__device__ __forceinline__ void tr_item64(const float* W, int ldw, int k0, int ncol0, const float* gk, bf16_t* WT, int ldd, int drow0, int dcol0, int lane) {
    const int n4 = lane & 15, kq = lane >> 4;
    const float* src = W + (size_t)(k0 + 16 * kq) * ldw + ncol0 + 4 * n4;
    f32x4 v[16];
#pragma unroll
    for (int i = 0; i < 16; ++i) v[i] = *(const f32x4*)(src + (size_t)i * ldw);
    if (gk) { const f32x4* gp = (const f32x4*)(gk + k0 + 16 * kq);
#pragma unroll
        for (int q = 0; q < 4; ++q) { const f32x4 gq = gp[q];
#pragma unroll
            for (int e = 0; e < 4; ++e) v[4 * q + e] = v[4 * q + e] * gq[e]; } }
    bf16_t* d = WT + (size_t)(drow0 + 4 * n4) * ldd + dcol0 + k0 + 16 * kq;
#pragma unroll
    for (int j = 0; j < 4; ++j) {
        u32x4 lo, hi;
        lo.x = cvt_pk_bf16(v[0][j], v[1][j]); lo.y = cvt_pk_bf16(v[2][j], v[3][j]); lo.z = cvt_pk_bf16(v[4][j], v[5][j]); lo.w = cvt_pk_bf16(v[6][j], v[7][j]);
        hi.x = cvt_pk_bf16(v[8][j], v[9][j]); hi.y = cvt_pk_bf16(v[10][j], v[11][j]); hi.z = cvt_pk_bf16(v[12][j], v[13][j]); hi.w = cvt_pk_bf16(v[14][j], v[15][j]);
        *(u32x4*)(d + (size_t)j * ldd) = lo; *(u32x4*)(d + (size_t)j * ldd + 8) = hi; }
}
__device__ __forceinline__ int in_srcmap(int n) {
    if (n < 1280) return n;
    if (n < 2304) { const int i = (n - 1280) >> 8, w = (n - 1280) & 255; return w < 128 ? 1792 + 128 * i + w : 2304 + 128 * i + (w - 128); }
    if (n < 3328) { const int i = (n - 2304) >> 8, w = (n - 2304) & 255; return w < 128 ? 1280 + 128 * i + w : 2816 + 128 * i + (w - 128); }
    return n;
}
__device__ __forceinline__ float row_to_bf16(const float* xrow, bf16_t* orow, int lane) {
    const f32x4* xr = (const f32x4*)xrow + lane; f32x4 v[4]; float s = 0.f;
#pragma unroll
    for (int j = 0; j < 4; ++j) { v[j] = xr[64 * j]; s += (v[j][0] * v[j][0] + v[j][1] * v[j][1]) + (v[j][2] * v[j][2] + v[j][3] * v[j][3]); }
    u32x2* o8 = (u32x2*)orow + lane;
#pragma unroll
    for (int j = 0; j < 4; ++j) { u32x2 w; w.x = cvt_pk_bf16(v[j][0], v[j][1]); w.y = cvt_pk_bf16(v[j][2], v[j][3]); o8[64 * j] = w; }
    return wave_sum(s);
}

typedef const __attribute__((address_space(4))) Args* KArgs;
#define PHASE_ARGS() KArgs ap = (KArgs)__builtin_amdgcn_kernarg_segment_ptr(); asm volatile("" : "+s"(ap)); unsigned char* const ws = ap->ws; float* const out = ap->out; (void)out
#define INF(i) ((const float*)ap->in[i])
#define WSP(T, off) ((T*)(ws + (off)))

__global__ void __launch_bounds__(NWAVES * 64, 2) fwd_kernel(Args args) {
    extern __shared__ __attribute__((aligned(16))) unsigned char lds[];
    LAS unsigned char* ldsl = (LAS unsigned char*)lds;
    volatile LAS unsigned* MISC = (volatile LAS unsigned*)(ldsl + MISC_OFF);
    const int tid = threadIdx.x, lane = tid & 63, wave = __builtin_amdgcn_readfirstlane(tid >> 6);
    const int G = gridDim.x; const int bx = blockIdx.x; const int vcu = (G % 8 == 0) ? (bx % 8) * (G / 8) + bx / 8 : bx;
    unsigned* const ctl = (unsigned*)(args.ws + WS_CTL);
    for (int u = tid; u < (LDS_BYTES - LDSCTL_OFF) / 4; u += NWAVES * 64) ((LAS unsigned*)(ldsl + LDSCTL_OFF))[u] = 0u;
    __syncthreads();
    XcdBarrier bar = xcd_barrier_post(ctl + CW_BAR, MISC + 8);
    const int lo = args.ph_lo, hi = args.ph_hi;
#define IN(k) (lo <= (k) && (k) < hi)
#define SEAM(k) do { if (IN(k) && IN((k) + 1)) { xcd_barrier(bar); if (PROBE_DUP & 32) xcd_barrier(bar); } } while (0)
    const int gw = vcu * NWAVES + wave, NGW = G * NWAVES;

    constexpr int CV_ALL = 16 * 116 + 3 * 8 * 16 + 16 * 16 + 2 * 16 * 8, CV_NOMEM = CV_ALL - 2 * 16 * 8;
#define CONVERT_LAYER_WEIGHTS(L, W0_, NW_, R0_, R1_) do {   \
        constexpr int I_IN = 16 * 116, I_P = 3 * 8 * 16, I_O = 16 * 16, I_M = 2 * 16 * 8, I_L = I_IN + I_P + I_O + I_M; const int l = (L); \
        for (int r = (R0_) + (W0_); r < (R1_); r += (NW_)) { \
            if (r < I_IN) { const int kb = r / 116, nb = r - kb * 116; tr_item64(INF(9) + (size_t)l * 1024 * NIN, NIN, 64 * kb, in_srcmap(64 * nb), INF(8) + l * 1024, WSP(bf16_t, WS_WIN) + (size_t)l * NIN * 1024, 1024, 64 * nb, 0, lane); } \
            else if (r < I_IN + I_P) { const int r1 = r - I_IN, br = r1 / 128, q = r1 - br * 128, kb = q >> 4, nb = q & 15; const float* W = (br == 0 ? INF(11) : br == 1 ? INF(14) : INF(18)) + (size_t)l * 512 * 1024; \
                tr_item64(W, 1024, 64 * kb, 64 * nb, nullptr, WSP(bf16_t, WS_WP) + (size_t)l * 1024 * 1536, 1536, 64 * nb, br * 512, lane); } \
            else if (r < I_IN + I_P + I_O) { const int r2 = r - I_IN - I_P, kb = r2 >> 4, nb = r2 & 15; tr_item64(INF(19) + (size_t)l * 1024 * 1024, 1024, 64 * kb, 64 * nb, nullptr, WSP(bf16_t, WS_WO) + (size_t)l * 1024 * 1024, 1024, 64 * nb, 0, lane); } \
            else { const int r3 = r - I_IN - I_P - I_O, kv = r3 >> 7, q = r3 & 127, kb = q >> 3, nb = q & 7; const float* W = (kv == 0 ? INF(16) : INF(17)) + (size_t)l * 1024 * 512; \
                tr_item64(W, 512, 64 * kb, 64 * nb, INF(15) + l * 1024, WSP(bf16_t, WS_WM) + (size_t)l * 1024 * 1024, 1024, kv * 512 + 64 * nb, 0, lane); } \
        } } while (0)

#ifndef NO_P0
    for (int rep_ = 0; rep_ < ((PROBE_DUP & 16) ? 2 : 1); ++rep_)
    if (IN(0)) {
        PHASE_ARGS();
        CONVERT_LAYER_WEIGHTS(0, gw, NGW, 0, CV_ALL);
        for (int l_ = 1; l_ < DEPTH; ++l_) CONVERT_LAYER_WEIGHTS(l_, gw, NGW, CV_NOMEM, CV_ALL);
        { const float* x_prompt = INF(0); const float* x_sample = INF(1); bf16_t* XB = WSP(bf16_t, WS_XB); float* SS = WSP(float, WS_SS);
          for (int m = gw; m < MT; m += NGW) { const float* xr = m < MP ? x_prompt + (size_t)m * 1024 : x_sample + (size_t)(m - MP) * 1024;
            const float s = row_to_bf16(xr, XB + (size_t)m * 1024, lane); if (lane == 0) SS[m] = s; } }
        { const float* mem_prompt = INF(7); bf16_t* MEMB = WSP(bf16_t, WS_MEMB); float* RMEM = WSP(float, WS_RMEM);
          for (int m = gw; m < MEMROWS; m += NGW) { const float s = row_to_bf16(mem_prompt + (size_t)m * 1024, MEMB + (size_t)m * 1024, lane); if (lane == 0) RMEM[m] = rsqrtf(s * (1.0f / 1024.0f) + EPS); } }
        {
            const size_t n1 = (size_t)DEPTH * DECB * 128 * 128 / 8, n2 = (size_t)DEPTH * DECB * 256 * 512 / 8, ntot = 2 * n1 + 2 * n2;
            for (size_t i = (size_t)vcu * 512 + tid; i < ntot; i += (size_t)G * 512) {
                const float* s; bf16_t* d; size_t j = i;
                if (j < n1) { s = INF(2); d = WSP(bf16_t, WS_CKB); } else if ((j -= n1) < n1) { s = INF(3); d = WSP(bf16_t, WS_CVB); } else if ((j -= n1) < n2) { s = INF(5); d = WSP(bf16_t, WS_CMK); } else { j -= n2; s = INF(6); d = WSP(bf16_t, WS_CMV); }
                const f32x4 a = *(const f32x4*)(s + j * 8), b = *(const f32x4*)(s + j * 8 + 4); st8(d + j * 8, a, b);
            }
        }
    }
#endif
    SEAM(0);

    for (int layer = 0; layer < DEPTH; ++layer) {
        const int pbase = 1 + 4 * layer;
#ifndef NO_A
        for (int rep_ = 0; rep_ < ((PROBE_DUP & 1) ? 2 : 1); ++rep_)
        if (IN(pbase)) {
            PHASE_ARGS();
            bf16_t* const XB = WSP(bf16_t, WS_XB); bf16_t* const WINl = WSP(bf16_t, WS_WIN) + (size_t)layer * NIN * 1024; bf16_t* const MG = WSP(bf16_t, WS_MG); float* const SS = WSP(float, WS_SS);
            pg8::Gemm g{(const char*)XB, (const char*)WINl, 1024, 1024, 1024, (long)((const char*)WSP(bf16_t, WS_MEMB) - (const char*)XB), (long)((const char*)WSP(bf16_t, WS_WM) - (const char*)WINl)};
            EpiIn E{layer, SS + (size_t)layer * MT, WSP(float, WS_RMEM), WSP(bf16_t, WS_Q), WSP(bf16_t, WS_K), WSP(bf16_t, WS_V), WSP(bf16_t, WS_GA), WSP(bf16_t, WS_U), WSP(bf16_t, WS_WB), WSP(bf16_t, WS_XQ), WSP(bf16_t, WS_GX), MG, WSP(bf16_t, WS_MK), WSP(bf16_t, WS_MV), out};
            if (bx >= G - NS) {
                const int si = bx - (G - NS);
                if (layer > 0) {
                    bf16_t* const ZB = WSP(bf16_t, WS_ZB);
                    { pg8::Gemm gc{(const char*)WSP(bf16_t, WS_ABX), (const char*)(WSP(bf16_t, WS_WP) + (size_t)(layer - 1) * 1024 * 1536), 1536, 1536, 512, 1024, 1024};
                      pg8::SchedS Sc{64, si, NS, 4, 3}; EpiBranch Ec{MG, ZB};
                      pg8::gemm_phase<EpiBranch, pg8::SchedS, true, true>(ldsl, gc, Sc, Ec); }
                    s_barrier_n(ctl + CW_SBAR, (unsigned)(NS * (2 * layer - 1)), ctl + CW_BAR + XB_TMO);
                    { pg8::Gemm gd{(const char*)ZB, (const char*)(WSP(bf16_t, WS_WO) + (size_t)(layer - 1) * 1024 * 1024), 1024, 1024, 1024, 0, 0};
                      pg8::SchedS Sd{64, si, NS, 4, 1};
                      EpiOut Ed{layer == 1 ? INF(0) : nullptr, INF(1), nullptr, XB, XB, SS + (size_t)layer * MT};
                      pg8::gemm_phase<EpiOut, pg8::SchedS, true, true>(ldsl, gd, Sd, Ed); }
                    s_barrier_n(ctl + CW_SBAR, (unsigned)(NS * (2 * layer)), ctl + CW_BAR + XB_TMO);
                }
                pg8::SchedS Sa{64, si, NS, NIN / 256, 1};
                pg8::gemm_phase<EpiIn, pg8::SchedS, true, true>(ldsl, g, Sa, E);
            } else {
                pg8::Sched S; S.init(MP, NIN, G - NS, bx, 1, layer == 0 ? 32 : 0);
                const int nfull = (MP / 256) * (NIN / 256) + (layer == 0 ? 32 : 0) - 7 * (G - NS);
                if (layer + 1 < DEPTH && bx >= nfull) CONVERT_LAYER_WEIGHTS(layer + 1, (bx - nfull) * NWAVES + wave, (G - NS - nfull) * NWAVES, 0, CV_NOMEM);
                pg8::gemm_phase<EpiIn, pg8::Sched, true, true>(ldsl, g, S, E);
            }
        }
#endif
        SEAM(pbase);
#ifndef NO_B
        for (int rep_ = 0; rep_ < ((PROBE_DUP & 2) ? 2 : 1); ++rep_)
        if (IN(pbase + 1)) {
            PHASE_ARGS();
            bf16_t* const ABX = WSP(bf16_t, WS_ABX);
#ifndef NO_W
            {
            const wattn::Ptrs WPt{WSP(bf16_t, WS_Q), WSP(bf16_t, WS_K), WSP(bf16_t, WS_V), WSP(bf16_t, WS_CKB), WSP(bf16_t, WS_CVB), WSP(bf16_t, WS_GA), ABX, INF(10)};
            for (int k_ = 0; k_ < 3; ++k_) { const int ui = k_ < 2 ? vcu + k_ * G : (vcu >= 32 && vcu < 48 ? 512 + (vcu - 32) : -1); if (ui < 0 || (k_ < 2 && ui >= 512)) continue;
                if (ui < 512) { const int g_ = ui & 1, bc = ui >> 1; wattn::unit((char*)lds, WPt, layer, false, bc >> 7, bc & 127, g_); }
                else { const int s = ui - 512; wattn::unit((char*)lds, WPt, layer, true, s >> 1, 0, s & 1); }
            }
            }
#endif
#ifndef NO_X
            {
            bf16_t* const XQ = WSP(bf16_t, WS_XQ); bf16_t* const GX = WSP(bf16_t, WS_GX);
            for (int k_ = 0; k_ < 2; ++k_) { const int ui = k_ == 0 ? vcu : (vcu >= 48 && vcu < 80 ? 256 + (vcu - 48) : -1); if (ui < 0 || (k_ == 0 && ui >= 256)) continue;
                if (ui < 256) { const int h = ui & 3, rest = ui >> 2, qb = rest & 31, b = rest >> 5; const size_t row0 = (size_t)b * SEQ + (size_t)qb * 256; const size_t mo = ((size_t)layer * 512 + b * 256) * 512 + h * 128;
                    xattn::body(XQ + row0 * 512 + h * 128, WSP(bf16_t, WS_MK) + mo, WSP(bf16_t, WS_MV) + mo, GX + row0 * 512 + h * 128, ABX + row0 * 1536 + 1024 + h * 128, 8, (char*)lds); }
                else { const int s = ui - 256, h = s & 3, b = s >> 2; const size_t row0 = (size_t)MP + 32 * b; const size_t co = ((size_t)(layer * DECB + b) * 256) * 512 + h * 128;
                    xattn::body(XQ + row0 * 512 + h * 128, WSP(bf16_t, WS_CMK) + co, WSP(bf16_t, WS_CMV) + co, GX + row0 * 512 + h * 128, ABX + row0 * 1536 + 1024 + h * 128, 1, (char*)lds); }
            }
            }
#endif
#ifndef NO_CV
            {
            const bf16_t* const Ub = WSP(bf16_t, WS_U); const bf16_t* const WBb = WSP(bf16_t, WS_WB);
            for (int k_ = 0; k_ < 2; ++k_) { const int it = k_ == 0 ? vcu : (vcu >= 80 && vcu < 84 ? 256 + (vcu - 80) : -1); if (it < 0 || (k_ == 0 && it >= 256)) continue;
                const int ch = lane * 8; const int row0 = it * 64 + wave * 8;
                const float* cw = INF(12) + (size_t)layer * 3 * 512 + ch; const float* cb = INF(13) + (size_t)layer * 512 + ch;
                float w0[8], w1[8], w2[8], bb_[8], um2[8], um1[8];
#pragma unroll
                for (int e = 0; e < 8; ++e) { w0[e] = cw[e]; w1[e] = cw[512 + e]; w2[e] = cw[1024 + e]; bb_[e] = cb[e]; um2[e] = 0.f; um1[e] = 0.f; }
                bool hist = false; const float* cc = nullptr;
                if (row0 < MP) { hist = (row0 & (SEQ - 1)) >= 2; }
                else { const int rs = row0 - MP, t = rs & 31, b = rs >> 5; hist = t >= 2; if (!hist) cc = INF(4) + ((size_t)(layer * DECB + b) * 2) * 512 + ch; }
                if (hist) { const u32x4 a = *(const u32x4*)(Ub + (size_t)(row0 - 2) * 512 + ch), b = *(const u32x4*)(Ub + (size_t)(row0 - 1) * 512 + ch);
                    um2[0] = bf_lo(a.x); um2[1] = bf_hi(a.x); um2[2] = bf_lo(a.y); um2[3] = bf_hi(a.y); um2[4] = bf_lo(a.z); um2[5] = bf_hi(a.z); um2[6] = bf_lo(a.w); um2[7] = bf_hi(a.w);
                    um1[0] = bf_lo(b.x); um1[1] = bf_hi(b.x); um1[2] = bf_lo(b.y); um1[3] = bf_hi(b.y); um1[4] = bf_lo(b.z); um1[5] = bf_hi(b.z); um1[6] = bf_lo(b.w); um1[7] = bf_hi(b.w); }
                else if (cc) {
#pragma unroll
                    for (int e = 0; e < 8; ++e) { um2[e] = cc[e]; um1[e] = cc[512 + e]; } }
#pragma unroll
                for (int rr = 0; rr < 8; ++rr) { const size_t row = (size_t)row0 + rr;
                    const u32x4 uu = *(const u32x4*)(Ub + row * 512 + ch), wb = *(const u32x4*)(WBb + row * 512 + ch);
                    float uc[8] = {bf_lo(uu.x), bf_hi(uu.x), bf_lo(uu.y), bf_hi(uu.y), bf_lo(uu.z), bf_hi(uu.z), bf_lo(uu.w), bf_hi(uu.w)};
                    const float wv[8] = {bf_lo(wb.x), bf_hi(wb.x), bf_lo(wb.y), bf_hi(wb.y), bf_lo(wb.z), bf_hi(wb.z), bf_lo(wb.w), bf_hi(wb.w)};
                    float ov[8];
#pragma unroll
                    for (int e = 0; e < 8; ++e) { ov[e] = wv[e] * (w0[e] * um2[e] + w1[e] * um1[e] + w2[e] * uc[e] + bb_[e]); um2[e] = um1[e]; um1[e] = uc[e]; }
                    u32x4 w; w.x = cvt_pk_bf16(ov[0], ov[1]); w.y = cvt_pk_bf16(ov[2], ov[3]); w.z = cvt_pk_bf16(ov[4], ov[5]); w.w = cvt_pk_bf16(ov[6], ov[7]);
                    *(u32x4*)(ABX + row * 1536 + 512 + ch) = w; }
            }
            }
#endif
        }
#endif
        SEAM(pbase + 1);
#ifndef NO_C
        for (int rep_ = 0; rep_ < ((PROBE_DUP & 4) ? 2 : 1); ++rep_)
        if (IN(pbase + 2)) {
            PHASE_ARGS();
            pg8::Gemm g{(const char*)WSP(bf16_t, WS_ABX), (const char*)(WSP(bf16_t, WS_WP) + (size_t)layer * 1024 * 1536), 1536, 1536, 512, 1024, 1024};
            pg8::Sched S; S.init(MP, 1024, G, bx, 3, 0);
            EpiBranch E{WSP(bf16_t, WS_MG), WSP(bf16_t, WS_ZB)};
            pg8::gemm_phase<EpiBranch, pg8::Sched, true, true>(ldsl, g, S, E);
        }
#endif
        SEAM(pbase + 2);
#ifndef NO_D
        for (int rep_ = ((PROBE_DUP & 8) ? 0 : 1); rep_ < 2; ++rep_)
        if (IN(pbase + 3)) {
            PHASE_ARGS();
            bf16_t* const XB = WSP(bf16_t, WS_XB);
            pg8::Gemm g{(const char*)WSP(bf16_t, WS_ZB), (const char*)(WSP(bf16_t, WS_WO) + (size_t)layer * 1024 * 1024), 1024, 1024, 1024, 0, 0};
            pg8::Sched S; S.init(MP, 1024, G, bx, 1, 0);
            EpiOut E{layer == 0 ? INF(0) : nullptr, INF(1), layer == DEPTH - 1 ? (rep_ ? out : WSP(float, WS_ZF)) : nullptr, XB, rep_ ? XB : WSP(bf16_t, WS_ABX), WSP(float, WS_SS) + (size_t)(rep_ ? layer + 1 : 6) * MT};
            pg8::gemm_phase<EpiOut, pg8::Sched, true, true>(ldsl, g, S, E);
        }
#endif
        SEAM(pbase + 3);
    }
    if (IN(N_PHASES - 1)) {
        PHASE_ARGS();
        const float* ssf = WSP(float, WS_SS) + (size_t)DEPTH * MT;
        int m0, m1, mstep;
        if (bx >= G - NS) {
            const int si = bx - (G - NS); bf16_t* const ZB = WSP(bf16_t, WS_ZB); bf16_t* const XB = WSP(bf16_t, WS_XB);
            { pg8::Gemm gc{(const char*)WSP(bf16_t, WS_ABX), (const char*)(WSP(bf16_t, WS_WP) + (size_t)(DEPTH - 1) * 1024 * 1536), 1536, 1536, 512, 1024, 1024};
              pg8::SchedS Sc{64, si, NS, 4, 3}; EpiBranch Ec{WSP(bf16_t, WS_MG), ZB};
              pg8::gemm_phase<EpiBranch, pg8::SchedS, true, true>(ldsl, gc, Sc, Ec); }
            s_barrier_n(ctl + CW_SBAR, (unsigned)(NS * (2 * DEPTH - 1)), ctl + CW_BAR + XB_TMO);
            { pg8::Gemm gd{(const char*)ZB, (const char*)(WSP(bf16_t, WS_WO) + (size_t)(DEPTH - 1) * 1024 * 1024), 1024, 1024, 1024, 0, 0};
              pg8::SchedS Sd{64, si, NS, 4, 1};
              EpiOut Ed{nullptr, nullptr, out, XB, XB, WSP(float, WS_SS) + (size_t)DEPTH * MT};
              pg8::gemm_phase<EpiOut, pg8::SchedS, true, true>(ldsl, gd, Sd, Ed); }
            s_barrier_n(ctl + CW_SBAR, (unsigned)(NS * (2 * DEPTH)), ctl + CW_BAR + XB_TMO);
            m0 = MP + si * NWAVES + wave; m1 = MT; mstep = NS * NWAVES;
        } else { m0 = bx * NWAVES + wave; m1 = MP; mstep = (G - NS) * NWAVES; }
        f32x4 gv[4];
#pragma unroll
        for (int j = 0; j < 4; ++j) gv[j] = ((const f32x4*)INF(20))[lane + 64 * j];
        for (int m = m0; m < m1; m += mstep) { const float r = rsqrtf(ssf[m] * (1.0f / 1024.0f) + EPS); f32x4* xr = (f32x4*)(out + (size_t)m * 1024) + lane;
#pragma unroll
            for (int j = 0; j < 4; ++j) xr[64 * j] = xr[64 * j] * r * gv[j]; }
    }
#undef IN
#undef SEAM
}

extern "C" void kernel_launch(void* const* d_in, const int* in_sizes, int n_in, void* d_out, int out_size, void* d_ws, size_t ws_size, hipStream_t stream) {
    static int grid = 0;
    if (grid == 0) {
        if (n_in != 21 || in_sizes[0] != MP * DM || out_size != (int)O_TOTAL || ws_size < WS_END) {
            fprintf(stderr, "kernel_launch: shape mismatch: n_in %d in0 %d out %d ws %zu (need %zu); nothing launched\n", n_in, n_in > 0 ? in_sizes[0] : -1, out_size, ws_size, (size_t)WS_END); grid = -1; return; }
        int dev = 0, cus = 0, per_cu = 0;
        if (hipGetDevice(&dev) != hipSuccess || hipDeviceGetAttribute(&cus, hipDeviceAttributeMultiprocessorCount, dev) != hipSuccess) { fprintf(stderr, "kernel_launch: device query failed\n"); grid = -1; return; }
        if (hipFuncSetAttribute((const void*)fwd_kernel, hipFuncAttributeMaxDynamicSharedMemorySize, LDS_BYTES) != hipSuccess) { fprintf(stderr, "kernel_launch: hipFuncSetAttribute failed\n"); grid = -1; return; }
        if (hipOccupancyMaxActiveBlocksPerMultiprocessor(&per_cu, (const void*)fwd_kernel, NWAVES * 64, LDS_BYTES) != hipSuccess || per_cu < 1) {
            fprintf(stderr, "kernel_launch: occupancy query reports %d workgroups per CU; nothing launched\n", per_cu); (void)hipGetLastError(); grid = -1; return; }
        (void)hipGetLastError();
        grid = cus;
    }
    if (grid < 0) return;
    if (hipMemsetAsync((char*)d_ws + WS_CTL, 0, CTL_ZERO_BYTES, stream) != hipSuccess) { fprintf(stderr, "kernel_launch: memset failed\n"); return; }
    Args a{};
    for (int i = 0; i < 21; ++i) a.in[i] = d_in[i];
    a.out = (float*)d_out; a.ws = (unsigned char*)d_ws;
#if MK_N_LAUNCHES == 1
    a.ph_lo = 0; a.ph_hi = N_PHASES;
    hipLaunchKernelGGL(fwd_kernel, dim3(grid), dim3(NWAVES * 64), LDS_BYTES, stream, a);
#else
    for (int p = 0; p < N_PHASES; ++p) { a.ph_lo = p; a.ph_hi = p + 1; hipLaunchKernelGGL(fwd_kernel, dim3(grid), dim3(NWAVES * 64), LDS_BYTES, stream, a); }
#endif
    const hipError_t le = hipPeekAtLastError();
    if (le != hipSuccess) fprintf(stderr, "kernel_launch: launch failed: %s\n", hipGetErrorName(le));
}
```
